# Optimizing an MI355X kernel written in HIP

```python
import math
import jax, jax.numpy as jnp
from jax import lax
import numpy as np

D_MODEL = 1024
BATCH = 16
SEQ = 2048
DEPTH = 4

N_META = 16
D_MIX = D_MODEL
HEAD_DIM = 64
RWKV_WIDTH = D_MIX // 2
SB_WIDTH = D_MIX - RWKV_WIDTH
RWKV_HEADS = RWKV_WIDTH // HEAD_DIM
SB_HEADS = SB_WIDTH // HEAD_DIM
DECAY_RANK = 64
A_RANK = 64
GATE_RANK = 128
D_FF = 4 * D_MODEL
SB_BLOCK = 128
RMS_EPS = 1e-6
GN_EPS = 1e-5 * HEAD_DIM
RWKV_SPLITS = [RWKV_WIDTH, 2 * RWKV_WIDTH, 3 * RWKV_WIDTH,
               3 * RWKV_WIDTH + DECAY_RANK, 3 * RWKV_WIDTH + DECAY_RANK + A_RANK]
RWKV_COLS = 3 * RWKV_WIDTH + DECAY_RANK + A_RANK + GATE_RANK
SB_COLS = 3 * SB_WIDTH
IN_COLS = RWKV_COLS + SB_COLS

kernel_name = "hymba_rwkv7_stickbreak_hybrid"


def rmsnorm(x, gain):
    x32 = x.astype(jnp.float32)
    y = x32 * lax.rsqrt(jnp.mean(jnp.square(x32), axis=-1, keepdims=True) + RMS_EPS) * gain.astype(jnp.float32)
    return y.astype(x.dtype)


def rwkv7_group(p, mu, w_decay_up, decay_bias, w_a_up, a_bias, w_g_up, k_k, k_a, r_k, lnx_gain, lnx_bias):
    B, T, _ = p.shape
    H, N = RWKV_HEADS, HEAD_DIM
    p = p.astype(jnp.float32)
    prev = jnp.pad(p[:, :-1], ((0, 0), (1, 0), (0, 0)))
    p = p + (prev - p) * mu.astype(jnp.float32)
    r, k, v, dw, da, dg = jnp.split(p, RWKV_SPLITS, axis=-1)
    w_log = -jax.nn.softplus(-(decay_bias + jnp.tanh(dw) @ w_decay_up)) - 0.5
    decay = jnp.exp(-jnp.exp(w_log))
    a = jax.nn.sigmoid(a_bias + da @ w_a_up)
    g = jax.nn.sigmoid(dg) @ w_g_up
    heads = lambda t: t.reshape(B, T, H, N)
    kk = heads(k * k_k)
    kk = kk * lax.rsqrt(jnp.sum(jnp.square(kk), axis=-1, keepdims=True) + 1e-12)
    k = k * (1.0 + (a - 1.0) * k_a)
    rh, kh, vh, wh, ah = heads(r), heads(k), heads(v), heads(decay), heads(a)

    def step(S, inp):
        r_t, w_t, k_t, v_t, kk_t, a_t = inp
        sa = jnp.einsum('bhvk,bhk->bhv', S, -kk_t)
        S = (S * w_t[:, :, None, :] + sa[..., None] * (kk_t * a_t)[:, :, None, :]
             + v_t[..., None] * k_t[:, :, None, :])
        return S, jnp.einsum('bhvk,bhk->bhv', S, r_t)

    xs = tuple(jnp.moveaxis(t, 1, 0) for t in (rh, wh, kh, vh, kk, ah))
    S0 = jnp.zeros((B, H, N, N), jnp.float32)
    _, y = lax.scan(step, S0, xs)
    y = jnp.moveaxis(y, 0, 1)
    mean = jnp.mean(y, axis=-1, keepdims=True)
    var = jnp.mean(jnp.square(y - mean), axis=-1, keepdims=True)
    y = (y - mean) * lax.rsqrt(var + GN_EPS) * lnx_gain.reshape(H, N) + lnx_bias.reshape(H, N)
    y = y + jnp.sum(rh * kh * r_k, axis=-1, keepdims=True) * vh
    return y.reshape(B, T, H * N) * g


def stick_breaking_group(q, k, v, out_gain):
    B, T, _ = q.shape
    H, N = SB_HEADS, HEAD_DIM
    to_heads = lambda t: t.astype(jnp.float32).reshape(B, T, H, N).transpose(0, 2, 1, 3)
    qh, kh, vh = to_heads(q), to_heads(k), to_heads(v)
    scale = 1.0 / math.sqrt(N)
    bounds = [(0, N_META)] + [(s, min(s + SB_BLOCK, T)) for s in range(N_META, T, SB_BLOCK)]
    outs = []
    for q0, q1 in bounds:
        qb, kb, vb = qh[:, :, q0:q1], kh[:, :, :q1], vh[:, :, :q1]
        z = jnp.einsum('bhqd,bhkd->bhqk', qb, kb) * scale
        t_idx = q0 + jnp.arange(q1 - q0)
        s_idx = jnp.arange(q1)
        mask = s_idx[None, :] < t_idx[:, None]
        log_beta = jax.nn.log_sigmoid(z)
        log_1m = jnp.where(mask, log_beta - z, 0.0)
        log_a = log_beta + lax.cumsum(log_1m, axis=3, reverse=True) - log_1m
        A = jnp.where(mask, jnp.exp(log_a), 0.0)
        outs.append(jnp.einsum('bhqk,bhkd->bhqd', A, vb))
    o = jnp.concatenate(outs, axis=2)
    o = o * lax.rsqrt(jnp.mean(jnp.square(o), axis=-1, keepdims=True) + RMS_EPS)
    o = o * out_gain.astype(jnp.float32).reshape(H, N)[None, :, None, :]
    return o.transpose(0, 2, 1, 3).reshape(B, T, H * N)


def setup_inputs(seed: int = 0) -> dict:
    key = jax.random.key(seed)
    ks = jax.random.split(key, 24)
    f = jnp.float32
    nrm = lambda k, shape, fan_in: jax.random.normal(k, shape, f) * (fan_in ** -0.5)
    gain = lambda k, shape: 1.0 + 0.05 * jax.random.normal(k, shape, f)
    return {
        "x": jax.random.normal(ks[0], (BATCH, SEQ, D_MODEL), f),
        "meta_tokens": jax.random.normal(ks[1], (N_META, D_MODEL), f),
        "g_pre_mix": gain(ks[2], (DEPTH, D_MODEL)),
        "g_post_mix": gain(ks[3], (DEPTH, D_MODEL)),
        "g_pre_ffn": gain(ks[4], (DEPTH, D_MODEL)),
        "g_post_ffn": gain(ks[5], (DEPTH, D_MODEL)),
        "w_in": nrm(ks[6], (DEPTH, D_MODEL, IN_COLS), D_MODEL),
        "tshift_mu": jax.random.uniform(ks[7], (DEPTH, RWKV_COLS), f),
        "w_decay_up": 0.1 * nrm(ks[8], (DEPTH, DECAY_RANK, RWKV_WIDTH), DECAY_RANK),
        "decay_bias": jax.random.uniform(ks[9], (DEPTH, RWKV_WIDTH), f, -5.0, 1.0),
        "w_a_up": nrm(ks[10], (DEPTH, A_RANK, RWKV_WIDTH), A_RANK),
        "a_bias": 0.1 * jax.random.normal(ks[11], (DEPTH, RWKV_WIDTH), f),
        "w_g_up": nrm(ks[12], (DEPTH, GATE_RANK, RWKV_WIDTH), GATE_RANK),
        "k_k": 0.85 + 0.05 * jax.random.normal(ks[13], (DEPTH, RWKV_WIDTH), f),
        "k_a": gain(ks[14], (DEPTH, RWKV_WIDTH)),
        "r_k": 0.1 * jax.random.normal(ks[15], (DEPTH, RWKV_HEADS, HEAD_DIM), f),
        "lnx_gain": gain(ks[16], (DEPTH, RWKV_WIDTH)),
        "lnx_bias": 0.02 * jax.random.normal(ks[17], (DEPTH, RWKV_WIDTH), f),
        "sb_out_gain": gain(ks[18], (DEPTH, SB_WIDTH)),
        "w_out": nrm(ks[19], (DEPTH, D_MIX, D_MODEL), D_MIX),
        "w_ffn_up": nrm(ks[20], (DEPTH, D_MODEL, D_FF), D_MODEL),
        "w_ffn_down": nrm(ks[21], (DEPTH, D_FF, D_MODEL), D_FF),
    }


def reference(x, meta_tokens, g_pre_mix, g_post_mix, g_pre_ffn, g_post_ffn, w_in, tshift_mu,
              w_decay_up, decay_bias, w_a_up, a_bias, w_g_up, k_k, k_a, r_k, lnx_gain, lnx_bias,
              sb_out_gain, w_out, w_ffn_up, w_ffn_down):
    B = x.shape[0]
    meta = jnp.broadcast_to(meta_tokens[None].astype(x.dtype), (B, N_META, D_MODEL))
    h = jnp.concatenate([meta, x], axis=1)
    for l in range(DEPTH):
        xn = rmsnorm(h, g_pre_mix[l])
        p = xn @ w_in[l]
        p_rwkv, p_sb = p[..., :RWKV_COLS], p[..., RWKV_COLS:]
        y_a = rwkv7_group(p_rwkv, tshift_mu[l], w_decay_up[l], decay_bias[l], w_a_up[l], a_bias[l],
                          w_g_up[l], k_k[l], k_a[l], r_k[l], lnx_gain[l], lnx_bias[l])
        q, k, v = jnp.split(p_sb, 3, axis=-1)
        y_b = stick_breaking_group(q, k, v, sb_out_gain[l])
        y = jnp.concatenate([y_a, y_b], axis=-1).astype(h.dtype) @ w_out[l]
        h = h + rmsnorm(y, g_post_mix[l])
        m = rmsnorm(h, g_pre_ffn[l])
        m = jnp.square(jax.nn.relu(m @ w_ffn_up[l])) @ w_ffn_down[l]
        h = h + rmsnorm(m, g_post_ffn[l])
    return h[:, N_META:]
```

```cpp
#include <hip/hip_runtime.h>
#include <hip/hip_cooperative_groups.h>
#include <cstdio>
#include <cstdint>
namespace cg = cooperative_groups;
namespace pg8 {
#define PG8_LAS __attribute__((address_space(3)))
#ifndef PG8_AUX
#define PG8_AUX 2
#endif
typedef unsigned short bf16_t;
typedef short bf16x8 __attribute__((ext_vector_type(8)));
typedef float f32x4 __attribute__((ext_vector_type(4)));
typedef unsigned u32x4 __attribute__((ext_vector_type(4)));
constexpr int BM = 256, BK = 64, HALF = 128, HTB = HALF * BK * 2  , STAGE_BYTES = 8 * HTB, NXCD = 8, WGM = 8;

__host__ __device__ __forceinline__ int lds_byte(int r, int c) { const int st = (r >> 4) * 2 + (c >> 5), rr = r & 15, cc = c & 31, ob = rr * 64 + cc * 2; return st * 1024 + (ob ^ (((ob >> 9) & 1) << 5)); }
__host__ __device__ __forceinline__ void stage_rc(int b, int& R, int& C) { const int st = b / 1024, sb = b % 1024, swz = sb ^ (((sb >> 9) & 1) << 5); R = (st >> 1) * 16 + swz / 64; C = (st & 1) * 32 + (swz % 64) / 2; }
__host__ __device__ __forceinline__ int perm32(int rho) { const int n = rho >> 4, i = rho & 15; return 8 * (i >> 2) + 4 * n + (i & 3); }

struct Unit { int pm, pn; };
struct Gemm { const bf16_t* A; const bf16_t* Bt; int M, N, K; };

struct StaticOrder {
    int nM, nN, nwg, G, c;
    __host__ __device__ void init(int M, int N, int G_, int c_) { nM = M / BM; nN = N / BM; nwg = nM * nN; G = G_; c = c_; }
    __host__ __device__ bool next(int i, Unit& u) const {
        const long L = (long)i * G + c; if (L >= nwg) return false;
        int wgid = (int)L; { const int q = nwg / NXCD, r = nwg % NXCD, xcd = wgid % NXCD, off = wgid / NXCD; wgid = (xcd < r ? xcd * (q + 1) : r * (q + 1) + (xcd - r) * q) + off; }
        const int nig = WGM * nN, gid = wgid / nig, fm = gid * WGM, gsz = (nM - fm) < WGM ? (nM - fm) : WGM;
        u.pm = fm + ((wgid % nig) % gsz); u.pn = (wgid % nig) / gsz; return true;
    }
    __device__ __forceinline__ void a_ready(const Unit&) const {}
    __device__ __forceinline__ void done(const Unit&) const {}
};

__device__ __forceinline__ unsigned cvt_pk_bf16(float lo, float hi) { unsigned r; asm volatile("v_cvt_pk_bf16_f32 %0, %1, %2" : "=v"(r) : "v"(lo), "v"(hi)); return r; }
typedef float f32x2 __attribute__((ext_vector_type(2)));
template <class Epi, class Sched, bool ALIGN_EPI = false, bool SP2 = false>
__device__ __forceinline__ void gemm_phase(PG8_LAS unsigned char* lds, const Gemm g, const Sched& S, const Epi& E) {
    int tid_ = threadIdx.x; asm volatile("" : "+v"(tid_));
    const int tid = tid_, wid = __builtin_amdgcn_readfirstlane(tid >> 6), lane = tid & 63, wr = wid >> 2, wc = wid & 3, fr = lane & 15, fq = lane >> 4;
    const int K = g.K, nt = K / BK;
    unsigned voffA[2], voffB[2];
#pragma unroll
    for (int i = 0; i < 2; ++i) { int R, C; stage_rc(tid * 16 + i * 8192, R, C); const int Rb = Epi::PERM ? ((R & ~31) + perm32(R & 31)) : R;
        voffA[i] = (unsigned)(R * K + C) * 2u; voffB[i] = (unsigned)(Rb * K + C) * 2u; }
    const size_t kstep = (size_t)(BK * 2);
    const size_t hstep = (size_t)HALF * K * 2;
    const size_t tstep = 2 * hstep;
    const unsigned ldsw = (unsigned)wid * 1024u;
    const int aoff = lds_byte(wr * 64 + fr, fq * 8), boff = lds_byte(wc * 32 + fr, fq * 8);
#define PG8_SA(b, h) (((b) * 2 + (h)) * HTB)
#define PG8_SB(b, h) ((4 + (b) * 2 + (h)) * HTB)
#define PG8_STAGE(bufoff, gbase, voff) do { _Pragma("unroll") for (int _i = 0; _i < 2; ++_i) \
        __builtin_amdgcn_global_load_lds((const unsigned*)((const char*)(gbase) + (voff)[_i]), (PG8_LAS unsigned*)(lds + (bufoff) + ldsw + _i * 8192), 16, 0, 0); } while (0)
#define PG8_LDA(dst, b, h) do { _Pragma("unroll") for (int m = 0; m < 4; ++m) _Pragma("unroll") for (int k = 0; k < 2; ++k) dst[m][k] = *(const PG8_LAS bf16x8*)(lds + PG8_SA(b, h) + aoff + m * 2048 + k * 1024); } while (0)
#define PG8_LDB(dst, b, h) do { _Pragma("unroll") for (int n = 0; n < 2; ++n) _Pragma("unroll") for (int k = 0; k < 2; ++k) dst[n][k] = *(const PG8_LAS bf16x8*)(lds + PG8_SB(b, h) + boff + n * 2048 + k * 1024); } while (0)
#define PG8_MMA(ai, bj, At, Bt) do { __builtin_amdgcn_s_setprio(1); _Pragma("unroll") for (int m = 0; m < 4; ++m) _Pragma("unroll") for (int n = 0; n < 2; ++n) _Pragma("unroll") for (int k = 0; k < 2; ++k) \
        acc[ai][bj][m][n] = __builtin_amdgcn_mfma_f32_16x16x32_bf16(Bt[n][k], At[m][k], acc[ai][bj][m][n], 0, 0, 0); __builtin_amdgcn_s_setprio(0); } while (0)
#define PG8_WAIT_V(n) asm volatile("s_waitcnt vmcnt(" #n ")" ::: "memory")
#define PG8_WAIT_L(n) asm volatile("s_waitcnt lgkmcnt(" #n ")" ::: "memory")
#define PG8_BAR __builtin_amdgcn_s_barrier()
#define PG8_SCHED __builtin_amdgcn_sched_barrier(0)
    Unit cur, nxt; int ui = 0;
    if (!S.next(0, cur)) return;
    f32x4 acc[2][2][4][2];
#pragma unroll
    for (int a = 0; a < 2; ++a)
#pragma unroll
        for (int b = 0; b < 2; ++b)
#pragma unroll
            for (int m = 0; m < 4; ++m)
#pragma unroll
                for (int n = 0; n < 2; ++n) acc[a][b][m][n] = (f32x4){0.f, 0.f, 0.f, 0.f};
    bf16x8 At[4][2], B0[2][2], B1[2][2];
    const char* cA = (const char*)g.A + (size_t)cur.pm * tstep; const char* cB = (const char*)g.Bt + (size_t)cur.pn * tstep;
    S.a_ready(cur);
    if constexpr (SP2) {
        PG8_STAGE(PG8_SB(0, 0), cB, voffB); PG8_STAGE(PG8_SB(0, 1), cB + hstep, voffB); PG8_STAGE(PG8_SA(0, 0), cA, voffA); PG8_STAGE(PG8_SA(0, 1), cA + hstep, voffA);
        if (wr == 1) PG8_BAR;
        PG8_WAIT_V(2); PG8_BAR;
        PG8_STAGE(PG8_SB(1, 0), cB + kstep, voffB); PG8_STAGE(PG8_SA(1, 0), cA + kstep, voffA); PG8_STAGE(PG8_SB(1, 1), cB + hstep + kstep, voffB);
        PG8_WAIT_V(6); PG8_BAR;
    } else {
        PG8_STAGE(PG8_SB(0, 0), cB, voffB); PG8_STAGE(PG8_SA(0, 0), cA, voffA); PG8_STAGE(PG8_SB(0, 1), cB + hstep, voffB); PG8_STAGE(PG8_SA(0, 1), cA + hstep, voffA);
        if (wr == 1) PG8_BAR;
        PG8_WAIT_V(4); PG8_BAR;
        PG8_STAGE(PG8_SB(1, 0), cB + kstep, voffB); PG8_STAGE(PG8_SA(1, 0), cA + kstep, voffA); PG8_STAGE(PG8_SB(1, 1), cB + hstep + kstep, voffB);
        PG8_WAIT_V(6); PG8_BAR;
    }
    for (;;) {
        const bool has_next = S.next(ui + 1, nxt);
        const char* nA = has_next ? (const char*)g.A + (size_t)nxt.pm * tstep : cA; const char* nB = has_next ? (const char*)g.Bt + (size_t)nxt.pn * tstep : cB;
        for (int t = 0; t < nt; t += 2) {
            const bool last = (t == nt - 2);
            const char* a1 = cA + (size_t)(t + 1) * kstep;
            const char* a2 = last ? nA : cA + (size_t)(t + 2) * kstep; const char* b2 = last ? nB : cB + (size_t)(t + 2) * kstep;
            const char* a3 = a2 + kstep; const char* b3 = b2 + kstep;
            if (last && has_next) S.a_ready(nxt);
            if constexpr (SP2) {
            PG8_LDB(B0, 0, 0); PG8_LDB(B1, 0, 1); PG8_SCHED; PG8_LDA(At, 0, 0); PG8_STAGE(PG8_SA(1, 1), a1 + hstep, voffA);
            PG8_WAIT_V(8); PG8_WAIT_L(0); PG8_BAR; PG8_MMA(0, 0, At, B0); PG8_MMA(0, 1, At, B1); PG8_BAR; PG8_SCHED;
            PG8_LDA(At, 0, 1); PG8_STAGE(PG8_SB(0, 0), b2, voffB); PG8_STAGE(PG8_SB(0, 1), b2 + hstep, voffB); PG8_STAGE(PG8_SA(0, 0), a2, voffA);
            PG8_WAIT_V(8); PG8_WAIT_L(0); PG8_BAR; PG8_MMA(1, 0, At, B0); PG8_MMA(1, 1, At, B1); PG8_BAR; PG8_SCHED;
            PG8_LDB(B0, 1, 0); PG8_LDB(B1, 1, 1); PG8_SCHED; PG8_LDA(At, 1, 0); PG8_STAGE(PG8_SA(0, 1), a2 + hstep, voffA);
            PG8_WAIT_V(8); PG8_WAIT_L(0); PG8_BAR; PG8_MMA(0, 0, At, B0); PG8_MMA(0, 1, At, B1); PG8_BAR; PG8_SCHED;
            PG8_LDA(At, 1, 1); PG8_STAGE(PG8_SB(1, 0), b3, voffB); PG8_STAGE(PG8_SB(1, 1), b3 + hstep, voffB); PG8_STAGE(PG8_SA(1, 0), a3, voffA);
            PG8_WAIT_V(8); PG8_WAIT_L(0); PG8_BAR; PG8_MMA(1, 0, At, B0); PG8_MMA(1, 1, At, B1); PG8_BAR; PG8_SCHED;
            } else {
            PG8_LDB(B0, 0, 0); PG8_SCHED; PG8_LDA(At, 0, 0); PG8_STAGE(PG8_SA(1, 1), a1 + hstep, voffA);
            PG8_WAIT_L(8); PG8_BAR; PG8_WAIT_L(0); PG8_MMA(0, 0, At, B0); PG8_BAR; PG8_SCHED;
            PG8_LDB(B1, 0, 1); PG8_STAGE(PG8_SB(0, 0), b2, voffB);
            PG8_BAR; PG8_WAIT_L(0); PG8_MMA(0, 1, At, B1); PG8_BAR;
            PG8_LDA(At, 0, 1); PG8_STAGE(PG8_SA(0, 0), a2, voffA);
            PG8_BAR; PG8_WAIT_L(0); PG8_MMA(1, 0, At, B0); PG8_BAR; PG8_SCHED;
            PG8_STAGE(PG8_SB(0, 1), b2 + hstep, voffB);
            PG8_WAIT_V(6); PG8_BAR; PG8_MMA(1, 1, At, B1); PG8_BAR;
            PG8_LDB(B0, 1, 0); PG8_SCHED; PG8_LDA(At, 1, 0); PG8_STAGE(PG8_SA(0, 1), a2 + hstep, voffA);
            PG8_WAIT_L(8); PG8_BAR; PG8_WAIT_L(0); PG8_MMA(0, 0, At, B0); PG8_BAR; PG8_SCHED;
            PG8_LDB(B1, 1, 1); PG8_STAGE(PG8_SB(1, 0), b3, voffB);
            PG8_BAR; PG8_WAIT_L(0); PG8_MMA(0, 1, At, B1); PG8_BAR;
            PG8_LDA(At, 1, 1); PG8_STAGE(PG8_SA(1, 0), a3, voffA);
            PG8_BAR; PG8_WAIT_L(0); PG8_MMA(1, 0, At, B0); PG8_BAR; PG8_SCHED;
            PG8_STAGE(PG8_SB(1, 1), b3 + hstep, voffB);
            PG8_WAIT_V(6); PG8_BAR; PG8_MMA(1, 1, At, B1); PG8_BAR;
            }
        }
        if constexpr (ALIGN_EPI) { if (wr == 0) PG8_BAR; }
        if constexpr (!Epi::AFTER_DRAIN) { E(acc, cur, wr, wc, fr, fq); S.done(cur); }
        if (!has_next) break;
#pragma unroll
        for (int a = 0; a < 2; ++a)
#pragma unroll
            for (int b = 0; b < 2; ++b)
#pragma unroll
                for (int m = 0; m < 4; ++m)
#pragma unroll
                    for (int n = 0; n < 2; ++n) acc[a][b][m][n] = (f32x4){0.f, 0.f, 0.f, 0.f};
        cur = nxt; cA = nA; cB = nB; ++ui;
        if constexpr (ALIGN_EPI) { if (wr == 1) PG8_BAR; }
    }
    PG8_WAIT_V(0);
    if constexpr (!ALIGN_EPI) { if (wr == 0) PG8_BAR; }
    PG8_BAR;
    if constexpr (Epi::AFTER_DRAIN) { E.fused(acc, cur, wr, wc, fr, fq, lds, wid, lane); S.done(cur); }
#undef PG8_SA
#undef PG8_SB
#undef PG8_STAGE
#undef PG8_LDA
#undef PG8_LDB
#undef PG8_MMA
#undef PG8_WAIT_V
#undef PG8_WAIT_L
#undef PG8_BAR
#undef PG8_SCHED
}
}


#define LAS __attribute__((address_space(3)))
typedef unsigned short bf16;
typedef short bf16x8 __attribute__((ext_vector_type(8)));
typedef float f32x4 __attribute__((ext_vector_type(4)));
typedef float f32x2 __attribute__((ext_vector_type(2)));
typedef unsigned u32x4 __attribute__((ext_vector_type(4)));
typedef unsigned u32x2 __attribute__((ext_vector_type(2)));

constexpr int NB = 16, SEQ = 2048, NMETA = 16, TT = SEQ + NMETA, DM = 1024, DFF = 4096, NL = 4;
constexpr int MR = NB * SEQ;
constexpr int MT = MR + NMETA;
constexpr int INC = 3328;
constexpr int C_R = 0, C_K = 512, C_V = 1024, C_DW = 1536, C_DA = 1600, C_DG = 1664, C_Q = 1792, C_SK = 2304, C_SV = 2816;
constexpr int NWAVES = 8, NTHR = 512;
constexpr int LDS_BYTES = 147456;

constexpr size_t WS_CTL = 0;
constexpr size_t WS_HM = 4096;
constexpr size_t WS_WIN = WS_HM + (size_t)NMETA * DM * 4;
constexpr size_t SZ_WIN = (size_t)INC * DM * 2;
constexpr size_t WS_WOUT = WS_WIN + NL * SZ_WIN;
constexpr size_t SZ_WOUT = (size_t)DM * DM * 2;
constexpr size_t WS_WUP = WS_WOUT + NL * SZ_WOUT;
constexpr size_t SZ_WUP = (size_t)DFF * DM * 2;
constexpr size_t WS_WDN = WS_WUP + NL * SZ_WUP;
constexpr size_t SZ_WDN = SZ_WUP;
constexpr size_t WS_WD = WS_WDN + NL * SZ_WDN;
constexpr size_t SZ_WD = (size_t)512 * 64 * 2;
constexpr size_t WS_WA = WS_WD + NL * SZ_WD;
constexpr size_t WS_WG = WS_WA + NL * SZ_WD;
constexpr size_t SZ_WG = (size_t)512 * 128 * 2;
constexpr size_t WS_RA = WS_WG + NL * SZ_WG;
constexpr size_t SZ_RA = (size_t)MT * DM * 2;
constexpr size_t WS_RB = WS_RA + SZ_RA;
constexpr size_t SZ_RB = (size_t)MT * DFF * 2;
constexpr size_t WS_T2HI = WS_RB + SZ_RB;
constexpr size_t WS_END = WS_T2HI + (size_t)MT * 512 * 4;

struct Params {
    const float* x; const float* meta; const float* g_pre_mix; const float* g_post_mix; const float* g_pre_ffn; const float* g_post_ffn;
    const float* w_in; const float* mu; const float* w_decay_up; const float* decay_bias; const float* w_a_up; const float* a_bias; const float* w_g_up;
    const float* k_k; const float* k_a; const float* r_k; const float* lnx_gain; const float* lnx_bias; const float* sb_gain;
    const float* w_out; const float* w_up; const float* w_dn;
    float* out; unsigned char* ws;
};

__device__ __forceinline__ int ltid() { int t = threadIdx.x; asm volatile("" : "+v"(t)); return t; }
__device__ __forceinline__ unsigned f2bf(float f) { unsigned u = __builtin_bit_cast(unsigned, f); return (u + 0x7fffu + ((u >> 16) & 1u)) >> 16; }
__device__ __forceinline__ unsigned pk2(float lo, float hi) { unsigned r; asm volatile("v_cvt_pk_bf16_f32 %0, %1, %2" : "=v"(r) : "v"(lo), "v"(hi)); return r; }
__device__ __forceinline__ float bflo(unsigned u) { return __builtin_bit_cast(float, u << 16); }
__device__ __forceinline__ float bfhi(unsigned u) { return __builtin_bit_cast(float, u & 0xffff0000u); }
__device__ __forceinline__ int tokrow(int b, int t) { return t < NMETA ? MR + t : b * SEQ + (t - NMETA); }
__device__ __forceinline__ float wave_sum(float v) {
#pragma unroll
    for (int o = 1; o < 64; o <<= 1) v += __shfl_xor(v, o);
    return v;
}
__device__ __forceinline__ float sum16(float v) {
#pragma unroll
    for (int o = 1; o < 16; o <<= 1) v += __shfl_xor(v, o);
    return v;
}
template <int CTRL> __device__ __forceinline__ float dppf(float x) {
    return __builtin_bit_cast(float, __builtin_amdgcn_update_dpp(0, __builtin_bit_cast(int, x), CTRL, 0xF, 0xF, true));
}
__device__ __forceinline__ float sum8(float v) {
    v += dppf<0xB1>(v);
    v += dppf<0x4E>(v);
    v += dppf<0x141>(v);
    return v;
}
__device__ __forceinline__ float fast_exp(float x) { return __builtin_amdgcn_exp2f(x * 1.4426950408889634f); }
__device__ __forceinline__ float fast_log(float x) { return __builtin_amdgcn_logf(x) * 0.6931471805599453f; }
__device__ __forceinline__ float softplusf(float z) { return fmaxf(z, 0.f) + fast_log(1.f + fast_exp(-fabsf(z))); }
__device__ __forceinline__ float sigmoidf_(float z) { return __builtin_amdgcn_rcpf(1.f + fast_exp(-z)); }

struct EpiOut {
    static constexpr bool PERM = true, AFTER_DRAIN = false;
    bf16* O; int ldc; int act;
    __device__ __forceinline__ void operator()(const f32x4 (&acc)[2][2][4][2], const pg8::Unit& u, int wr, int wc, int fr, int fq) const {
        const int row0 = u.pm * 256 + wr * 64 + fr, col0 = u.pn * 256 + wc * 32 + 8 * fq;
#pragma unroll
        for (int ai = 0; ai < 2; ++ai)
#pragma unroll
            for (int m = 0; m < 4; ++m) { bf16* rowp = O + (size_t)(row0 + ai * 128 + m * 16) * ldc + col0;
#pragma unroll
                for (int bj = 0; bj < 2; ++bj) { f32x4 v0 = acc[ai][bj][m][0], v1 = acc[ai][bj][m][1];
                    if (act) {
#pragma unroll
                        for (int e = 0; e < 4; ++e) { float a = fmaxf(v0[e], 0.f), b = fmaxf(v1[e], 0.f); v0[e] = a * a; v1[e] = b * b; } }
                    u32x4 w; w.x = pk2(v0[0], v0[1]); w.y = pk2(v0[2], v0[3]); w.z = pk2(v1[0], v1[1]); w.w = pk2(v1[2], v1[3]);
                    *(u32x4*)(rowp + bj * 128) = w; } }
    }
};

struct EpiF32Split {
    static constexpr bool PERM = true, AFTER_DRAIN = false;
    float* lo; float* hi;
    __device__ __forceinline__ void operator()(const f32x4 (&acc)[2][2][4][2], const pg8::Unit& u, int wr, int wc, int fr, int fq) const {
        const int row0 = u.pm * 256 + wr * 64 + fr, col0 = (u.pn & 1) * 256 + wc * 32 + 8 * fq;
        float* base = (u.pn < 2) ? lo : hi;
#pragma unroll
        for (int ai = 0; ai < 2; ++ai)
#pragma unroll
            for (int m = 0; m < 4; ++m) { float* rowp = base + (size_t)(row0 + ai * 128 + m * 16) * 512 + col0;
#pragma unroll
                for (int bj = 0; bj < 2; ++bj) { *(f32x4*)(rowp + bj * 128) = acc[ai][bj][m][0]; *(f32x4*)(rowp + bj * 128 + 4) = acc[ai][bj][m][1]; } }
    }
};

__device__ __forceinline__ void meta_gemm(const bf16* A, const bf16* Bt, int N, int K, bf16* O, int act, int gw, int ngw, int lane, float* flo = nullptr, float* fhi = nullptr) {
    const int i = lane & 15, g = lane >> 4;
    for (int task = gw; task < N / 16; task += ngw) {
        const int n0 = task * 16;
        const bf16* ap = Bt + (size_t)(n0 + i) * K + 8 * g;
        const bf16* bp = A + (size_t)(MR + i) * K + 8 * g;
        f32x4 acc = {0.f, 0.f, 0.f, 0.f};
#pragma unroll 4
        for (int k0 = 0; k0 < K; k0 += 32) {
            bf16x8 a = *(const bf16x8*)(ap + k0), b = *(const bf16x8*)(bp + k0);
            acc = __builtin_amdgcn_mfma_f32_16x16x32_bf16(a, b, acc, 0, 0, 0);
        }
        if (act) {
#pragma unroll
            for (int e = 0; e < 4; ++e) { float a = fmaxf(acc[e], 0.f); acc[e] = a * a; } }
        if (flo) { float* base = (n0 < 512) ? flo : fhi; *(f32x4*)(base + (size_t)(MR + i) * 512 + (n0 & 511) + 4 * g) = acc; }
        else { u32x2 w; w.x = pk2(acc[0], acc[1]); w.y = pk2(acc[2], acc[3]);
        *(u32x2*)(O + (size_t)(MR + i) * N + n0 + 4 * g) = w; }
    }
}

__device__ __forceinline__ void transpose_item(const float* W, int K, int N, bf16* WT, LAS float* scr, int item, int lane) {
    const int nblk = N / 32, kb = item / nblk, nb = item % nblk, k0 = 64 * kb, n0 = 32 * nb;
#pragma unroll 8
    for (int i = 0; i < 32; ++i) { const int kk = 2 * i + (lane >> 5); scr[kk * 33 + (lane & 31)] = W[(size_t)(k0 + kk) * N + n0 + (lane & 31)]; }
    asm volatile("s_waitcnt lgkmcnt(0)" ::: "memory");
    const int c = lane & 7;
#pragma unroll
    for (int j = 0; j < 4; ++j) { const int n = (lane >> 3) + 8 * j; const LAS float* s = scr + (8 * c) * 33 + n;
        u32x4 o; o.x = pk2(s[0 * 33], s[1 * 33]); o.y = pk2(s[2 * 33], s[3 * 33]); o.z = pk2(s[4 * 33], s[5 * 33]); o.w = pk2(s[6 * 33], s[7 * 33]);
        *(u32x4*)(WT + (size_t)(n0 + n) * K + k0 + 8 * c) = o; }
    asm volatile("s_waitcnt lgkmcnt(0)" ::: "memory");
}
__device__ __forceinline__ void conv_phase(const Params& p, LAS unsigned char* lds) {
    const int t_ = ltid(), lane = t_ & 63, wave = t_ >> 6, gw = blockIdx.x * NWAVES + wave, ngw = gridDim.x * NWAVES;
    LAS float* scr = (LAS float*)(lds + wave * 16384);
    constexpr int I_IN = 16 * 104, I_OUT = 16 * 32, I_UP = 16 * 128, I_DN = 64 * 32, I_D = 16, I_A = 16, I_G = 32;
    constexpr int PER = I_IN + I_OUT + I_UP + I_DN + I_D + I_A + I_G;
    for (int it = gw; it < NL * PER; it += ngw) {
        const int l = it / PER; int r = it % PER;
        if (r < I_IN) { transpose_item(p.w_in + (size_t)l * DM * INC, DM, INC, (bf16*)(p.ws + WS_WIN + l * SZ_WIN), scr, r, lane); continue; } r -= I_IN;
        if (r < I_OUT) { transpose_item(p.w_out + (size_t)l * DM * DM, DM, DM, (bf16*)(p.ws + WS_WOUT + l * SZ_WOUT), scr, r, lane); continue; } r -= I_OUT;
        if (r < I_UP) { transpose_item(p.w_up + (size_t)l * DM * DFF, DM, DFF, (bf16*)(p.ws + WS_WUP + l * SZ_WUP), scr, r, lane); continue; } r -= I_UP;
        if (r < I_DN) { transpose_item(p.w_dn + (size_t)l * DFF * DM, DFF, DM, (bf16*)(p.ws + WS_WDN + l * SZ_WDN), scr, r, lane); continue; } r -= I_DN;
        if (r < I_D) { transpose_item(p.w_decay_up + (size_t)l * 64 * 512, 64, 512, (bf16*)(p.ws + WS_WD + l * SZ_WD), scr, r, lane); continue; } r -= I_D;
        if (r < I_A) { transpose_item(p.w_a_up + (size_t)l * 64 * 512, 64, 512, (bf16*)(p.ws + WS_WA + l * SZ_WD), scr, r, lane); continue; } r -= I_A;
        transpose_item(p.w_g_up + (size_t)l * 128 * 512, 128, 512, (bf16*)(p.ws + WS_WG + l * SZ_WG), scr, r, lane);
    }
}

__device__ __forceinline__ void norm_phase(const float* T, const float* Thi, const float* g1, const float* hin_real, const float* hin_meta, float* hout_real, float* hout_meta,
                                           const float* g2, bf16* xn) {
    const int t_ = ltid(), lane = t_ & 63, gw = blockIdx.x * NWAVES + (t_ >> 6), ngw = gridDim.x * NWAVES;
    for (int m = gw; m < MT; m += ngw) {
        const float* hi = m < MR ? hin_real + (size_t)m * DM : hin_meta + (size_t)(m - MR) * DM;
        float* ho = m < MR ? hout_real + (size_t)m * DM : hout_meta + (size_t)(m - MR) * DM;
        f32x4 h[4];
#pragma unroll
        for (int j = 0; j < 4; ++j) h[j] = *((const f32x4*)hi + lane + 64 * j);
        if (T) {
            f32x4 t[4]; float ss = 0.f;
#pragma unroll
            for (int j = 0; j < 4; ++j) { t[j] = *((const f32x4*)((j < 2 ? T : Thi) + (size_t)m * 512) + lane + 64 * (j & 1));
                ss += (t[j].x * t[j].x + t[j].y * t[j].y) + (t[j].z * t[j].z + t[j].w * t[j].w); }
            const float r1 = 1.f / sqrtf(wave_sum(ss) * (1.f / DM) + 1e-6f);
#pragma unroll
            for (int j = 0; j < 4; ++j) { f32x4 gg = *((const f32x4*)g1 + lane + 64 * j); h[j] = h[j] + t[j] * r1 * gg; *((f32x4*)ho + lane + 64 * j) = h[j]; }
        }
        if (g2) {
            float ss = 0.f;
#pragma unroll
            for (int j = 0; j < 4; ++j) ss += (h[j].x * h[j].x + h[j].y * h[j].y) + (h[j].z * h[j].z + h[j].w * h[j].w);
            const float r2 = 1.f / sqrtf(wave_sum(ss) * (1.f / DM) + 1e-6f);
            u32x2* o = (u32x2*)(xn + (size_t)m * DM) + lane;
#pragma unroll
            for (int j = 0; j < 4; ++j) { f32x4 gg = *((const f32x4*)g2 + lane + 64 * j); f32x4 v = h[j] * r2 * gg;
                u32x2 w; w.x = pk2(v.x, v.y); w.y = pk2(v.z, v.w); o[64 * j] = w; }
        }
    }
}

constexpr int RW_CH = 32;
constexpr int RW_R = 0, RW_W = 8192, RW_K = 16384, RW_V = 24576, RW_KKN = 32768, RW_B = 40960, RW_Y = 49152, RW_G = 57344;
constexpr int RW_TD = 65536, RW_DA = 70144, RW_SG = 74752, RW_BON = 83456;

__device__ __forceinline__ void rwkv_chain(const Params& p, int l, int b, int h, LAS unsigned char* lds, int tid) {
    const int wave = tid >> 6, lane = tid & 63;
    const bf16* P = (const bf16*)(p.ws + WS_RB);
    bf16* Yo = (bf16*)(p.ws + WS_RA);
    LAS float* R = (LAS float*)(lds + RW_R); LAS float* W = (LAS float*)(lds + RW_W); LAS float* Kx = (LAS float*)(lds + RW_K); LAS float* V = (LAS float*)(lds + RW_V);
    LAS float* KKN = (LAS float*)(lds + RW_KKN); LAS float* BV = (LAS float*)(lds + RW_B); LAS float* Y = (LAS float*)(lds + RW_Y); LAS float* G = (LAS float*)(lds + RW_G);
    LAS bf16* TD = (LAS bf16*)(lds + RW_TD); LAS bf16* DA = (LAS bf16*)(lds + RW_DA); LAS bf16* SG = (LAS bf16*)(lds + RW_SG); LAS float* BON = (LAS float*)(lds + RW_BON);
    const float* mu = p.mu + (size_t)l * 1792;
    const int mt = wave & 1, nt = wave >> 1, fi = lane & 15, fg = lane >> 4;
    bf16x8 wdF[2], waF[2], wgF[4];
    {
        const bf16* wd = (const bf16*)(p.ws + WS_WD + l * SZ_WD) + (size_t)(h * 64 + nt * 16 + fi) * 64 + 8 * fg;
        const bf16* wa = (const bf16*)(p.ws + WS_WA + l * SZ_WD) + (size_t)(h * 64 + nt * 16 + fi) * 64 + 8 * fg;
        const bf16* wg = (const bf16*)(p.ws + WS_WG + l * SZ_WG) + (size_t)(h * 64 + nt * 16 + fi) * 128 + 8 * fg;
        wdF[0] = *(const bf16x8*)wd; wdF[1] = *(const bf16x8*)(wd + 32);
        waF[0] = *(const bf16x8*)wa; waF[1] = *(const bf16x8*)(wa + 32);
#pragma unroll
        for (int k = 0; k < 4; ++k) wgF[k] = *(const bf16x8*)(wg + 32 * k);
    }
    const int cB = h * 64 + nt * 16 + fi;
    const float dbias = p.decay_bias[l * 512 + cB], abias = p.a_bias[l * 512 + cB];
    const int tokC = tid >> 4, ch4 = (tid & 15) * 4, cC = h * 64 + ch4;
    const f32x4 kkv = *(const f32x4*)(p.k_k + l * 512 + cC), kav = *(const f32x4*)(p.k_a + l * 512 + cC), rkv = *(const f32x4*)(p.r_k + l * 512 + cC);
    const f32x4 lgv = *(const f32x4*)(p.lnx_gain + l * 512 + cC), lbv = *(const f32x4*)(p.lnx_bias + l * 512 + cC);
    const int vrow = tid >> 3, kq = tid & 7;
    f32x2 S[4];
#pragma unroll
    for (int j = 0; j < 4; ++j) S[j] = (f32x2){0.f, 0.f};

    for (int t0 = 0; t0 < TT; ) {
        const int ntok = (t0 == 0) ? NMETA : RW_CH;
        for (int item = tid; item < ntok * 56; item += NTHR) {
            const int i = item / 56, gi = item % 56, t = t0 + i;
            int col, mcol;
            if (gi < 24) { col = (gi >> 3) * 512 + h * 64 + (gi & 7) * 8; mcol = col; }
            else { col = C_DW + (gi - 24) * 8; mcol = col; }
            const u32x4 cur = *(const u32x4*)(P + (size_t)tokrow(b, t) * INC + col);
            u32x4 prv = {0u, 0u, 0u, 0u};
            if (t > 0) prv = *(const u32x4*)(P + (size_t)tokrow(b, t - 1) * INC + col);
            const f32x4 m0 = *(const f32x4*)(mu + mcol), m1 = *(const f32x4*)(mu + mcol + 4);
            float xv[8];
            {
                const unsigned cu[4] = {cur.x, cur.y, cur.z, cur.w}, pu[4] = {prv.x, prv.y, prv.z, prv.w};
                const float mm[8] = {m0.x, m0.y, m0.z, m0.w, m1.x, m1.y, m1.z, m1.w};
#pragma unroll
                for (int e = 0; e < 4; ++e) { float c0 = bflo(cu[e]), c1 = bfhi(cu[e]), q0 = bflo(pu[e]), q1 = bfhi(pu[e]);
                    xv[2 * e] = c0 + (q0 - c0) * mm[2 * e]; xv[2 * e + 1] = c1 + (q1 - c1) * mm[2 * e + 1]; }
            }
            if (gi < 24) {
                LAS float* dst = (gi < 8 ? R : (gi < 16 ? Kx : V)) + i * 64 + (gi & 7) * 8;
                *(LAS f32x4*)dst = (f32x4){xv[0], xv[1], xv[2], xv[3]}; *(LAS f32x4*)(dst + 4) = (f32x4){xv[4], xv[5], xv[6], xv[7]};
            } else if (gi < 32) {
                float tv[8];
#pragma unroll
                for (int e = 0; e < 8; ++e) tv[e] = 1.f - 2.f * __builtin_amdgcn_rcpf(fast_exp(2.f * xv[e]) + 1.f);
                u32x4 w; w.x = pk2(tv[0], tv[1]); w.y = pk2(tv[2], tv[3]); w.z = pk2(tv[4], tv[5]); w.w = pk2(tv[6], tv[7]);
                *(LAS u32x4*)(TD + i * 72 + (gi - 24) * 8) = w;
            } else if (gi < 40) {
                u32x4 w; w.x = pk2(xv[0], xv[1]); w.y = pk2(xv[2], xv[3]); w.z = pk2(xv[4], xv[5]); w.w = pk2(xv[6], xv[7]);
                *(LAS u32x4*)(DA + i * 72 + (gi - 32) * 8) = w;
            } else {
                float tv[8];
#pragma unroll
                for (int e = 0; e < 8; ++e) tv[e] = sigmoidf_(xv[e]);
                u32x4 w; w.x = pk2(tv[0], tv[1]); w.y = pk2(tv[2], tv[3]); w.z = pk2(tv[4], tv[5]); w.w = pk2(tv[6], tv[7]);
                *(LAS u32x4*)(SG + i * 136 + (gi - 40) * 8) = w;
            }
        }
        __syncthreads();
        {
            f32x4 ad = {0.f, 0.f, 0.f, 0.f}, aa = ad, ag = ad;
#pragma unroll
            for (int ks = 0; ks < 2; ++ks) {
                bf16x8 fa = *(const LAS bf16x8*)(TD + (16 * mt + fi) * 72 + 32 * ks + 8 * fg);
                ad = __builtin_amdgcn_mfma_f32_16x16x32_bf16(fa, wdF[ks], ad, 0, 0, 0);
                bf16x8 fb = *(const LAS bf16x8*)(DA + (16 * mt + fi) * 72 + 32 * ks + 8 * fg);
                aa = __builtin_amdgcn_mfma_f32_16x16x32_bf16(fb, waF[ks], aa, 0, 0, 0);
            }
#pragma unroll
            for (int ks = 0; ks < 4; ++ks) {
                bf16x8 fc = *(const LAS bf16x8*)(SG + (16 * mt + fi) * 136 + 32 * ks + 8 * fg);
                ag = __builtin_amdgcn_mfma_f32_16x16x32_bf16(fc, wgF[ks], ag, 0, 0, 0);
            }
#pragma unroll
            for (int r = 0; r < 4; ++r) {
                const int tok = 16 * mt + 4 * fg + r, o = tok * 64 + nt * 16 + fi;
                const float xd = dbias + ad[r];
                const float wlog = -softplusf(-xd) - 0.5f;
                W[o] = fast_exp(-fast_exp(wlog));
                BV[o] = sigmoidf_(abias + aa[r]);
                G[o] = ag[r];
            }
        }
        __syncthreads();
        {
            const int o = tokC * 64 + ch4;
            const f32x4 k = *(const LAS f32x4*)(Kx + o), a = *(const LAS f32x4*)(BV + o), r = *(const LAS f32x4*)(R + o);
            f32x4 kk = k * kkv;
            const float ss = sum16((kk.x * kk.x + kk.y * kk.y) + (kk.z * kk.z + kk.w * kk.w));
            const float inv = 1.f / sqrtf(ss + 1e-12f);
            kk = kk * inv;
            const f32x4 km = k * (1.f + (a - 1.f) * kav);
            const f32x4 bb = r * km * rkv;
            const float bon = sum16((bb.x + bb.y) + (bb.z + bb.w));
            *(LAS f32x4*)(KKN + o) = -kk; *(LAS f32x4*)(BV + o) = kk * a; *(LAS f32x4*)(Kx + o) = km;
            if ((tid & 15) == 0) BON[tokC] = bon;
        }
        __syncthreads();
        {
#pragma unroll 2
            for (int i = 0; i < ntok; ++i) {
                const int o = i * 64 + kq * 8;
                const f32x4 n0 = *(const LAS f32x4*)(KKN + o), n1 = *(const LAS f32x4*)(KKN + o + 4);
                const f32x4 w0 = *(const LAS f32x4*)(W + o), w1 = *(const LAS f32x4*)(W + o + 4);
                const f32x4 b0 = *(const LAS f32x4*)(BV + o), b1 = *(const LAS f32x4*)(BV + o + 4);
                const f32x4 k0 = *(const LAS f32x4*)(Kx + o), k1 = *(const LAS f32x4*)(Kx + o + 4);
                const f32x4 r0 = *(const LAS f32x4*)(R + o), r1 = *(const LAS f32x4*)(R + o + 4);
                const float vv = V[i * 64 + vrow];
                f32x2 s2 = S[0] * (f32x2){n0.x, n0.y};
                s2 = __builtin_elementwise_fma(S[1], (f32x2){n0.z, n0.w}, s2);
                f32x2 s3 = S[2] * (f32x2){n1.x, n1.y};
                s3 = __builtin_elementwise_fma(S[3], (f32x2){n1.z, n1.w}, s3);
                s2 = s2 + s3;
                const float sa = sum8(s2.x + s2.y);
                const f32x2 sa2 = {sa, sa}, vv2 = {vv, vv};
                S[0] = __builtin_elementwise_fma(S[0], (f32x2){w0.x, w0.y}, __builtin_elementwise_fma(sa2, (f32x2){b0.x, b0.y}, vv2 * (f32x2){k0.x, k0.y}));
                S[1] = __builtin_elementwise_fma(S[1], (f32x2){w0.z, w0.w}, __builtin_elementwise_fma(sa2, (f32x2){b0.z, b0.w}, vv2 * (f32x2){k0.z, k0.w}));
                S[2] = __builtin_elementwise_fma(S[2], (f32x2){w1.x, w1.y}, __builtin_elementwise_fma(sa2, (f32x2){b1.x, b1.y}, vv2 * (f32x2){k1.x, k1.y}));
                S[3] = __builtin_elementwise_fma(S[3], (f32x2){w1.z, w1.w}, __builtin_elementwise_fma(sa2, (f32x2){b1.z, b1.w}, vv2 * (f32x2){k1.z, k1.w}));
                f32x2 y2 = S[0] * (f32x2){r0.x, r0.y};
                y2 = __builtin_elementwise_fma(S[1], (f32x2){r0.z, r0.w}, y2);
                f32x2 y3 = S[2] * (f32x2){r1.x, r1.y};
                y3 = __builtin_elementwise_fma(S[3], (f32x2){r1.z, r1.w}, y3);
                y2 = y2 + y3;
                const float y = sum8(y2.x + y2.y);
                if (kq == 0) Y[i * 64 + vrow] = y;
            }
        }
        __syncthreads();
        if (tokC < ntok && (t0 > 0 || b == 0)) {
            const int o = tokC * 64 + ch4;
            const f32x4 y = *(const LAS f32x4*)(Y + o);
            const float mean = sum16((y.x + y.y) + (y.z + y.w)) * (1.f / 64.f);
            const f32x4 d = y - mean;
            const float var = sum16((d.x * d.x + d.y * d.y) + (d.z * d.z + d.w * d.w)) * (1.f / 64.f);
            const float rs = 1.f / sqrtf(var + 6.4e-4f);
            f32x4 yn = d * rs * lgv + lbv;
            const f32x4 vv = *(const LAS f32x4*)(V + o), gg = *(const LAS f32x4*)(G + o);
            yn = (yn + BON[tokC] * vv) * gg;
            u32x2 w; w.x = pk2(yn.x, yn.y); w.y = pk2(yn.z, yn.w);
            *(u32x2*)(Yo + (size_t)tokrow(b, t0 + tokC) * DM + cC) = w;
        } else if (tokC < ntok) {
        }
        __syncthreads();
        t0 += ntok;
    }
}

constexpr int SB_KS = 0, SB_VT = 9216, SB_Q = 18432;
constexpr float SB_THR = 90.f;

__device__ __forceinline__ void sb_unit(const Params& p, int l, int b, int h, int qb, LAS unsigned char* lds, int tid) {
    const int wave = tid >> 6, lane = tid & 63, ql = lane & 15, g = lane >> 4;
    const bf16* P = (const bf16*)(p.ws + WS_RB);
    bf16* Yo = (bf16*)(p.ws + WS_RA);
    LAS bf16* Ks = (LAS bf16*)(lds + SB_KS); LAS bf16* Vt = (LAS bf16*)(lds + SB_VT);
    const int tq = (qb < 0 ? 0 : NMETA + 128 * qb) + 16 * wave + ql;
    const bool wave_valid = (qb >= 0) || (wave == 0);
    const int tqc = wave_valid ? tq : 0;
    bf16x8 qF[2];
    {
        const bf16* qp = P + (size_t)tokrow(b, tqc) * INC + C_Q + h * 64 + 8 * g;
        qF[0] = *(const bf16x8*)qp; qF[1] = *(const bf16x8*)(qp + 32);
    }
    unsigned P01, P23; const unsigned ONES = 0x3F803F80u;
    { const unsigned p0 = (4 * g + 0 > ql) ? 0x3F80u : 0u, p1 = (4 * g + 1 > ql) ? 0x3F80u : 0u, p2 = (4 * g + 2 > ql) ? 0x3F80u : 0u, p3 = (4 * g + 3 > ql) ? 0x3F80u : 0u;
      P01 = p0 | (p1 << 16); P23 = p2 | (p3 << 16); }
    const bf16x8 FA = __builtin_bit_cast(bf16x8, (u32x4){P01, P23, ONES, ONES});
    const bf16x8 FB = __builtin_bit_cast(bf16x8, (u32x4){0u, 0u, P01, P23});
    const bf16x8 F1 = __builtin_bit_cast(bf16x8, (u32x4){ONES, ONES, ONES, ONES});
    f32x4 O[4];
#pragma unroll
    for (int d = 0; d < 4; ++d) O[d] = (f32x4){0.f, 0.f, 0.f, 0.f};
    float carry = 0.f;
    const int wave_tq_max = (qb < 0 ? 0 : NMETA + 128 * qb) + 16 * wave + 15;
    const int i_hi = qb < 0 ? 0 : 2 * qb + 2;
    const int kap = tid >> 3, piece = tid & 7;
    const int slot = (kap >> 5) * 32 + ((kap >> 2) & 3) * 8 + ((kap >> 4) & 1) * 4 + (kap & 3);
    bool wave_done = !wave_valid;
    for (int it = i_hi; it >= 0; --it) {
        const int tk0 = NMETA + 64 * (it - 1);
        {
            const int tk = tk0 + kap;
            u32x4 kv = {0u, 0u, 0u, 0u}, vv = kv;
            if (tk >= 0) { const bf16* rp = P + (size_t)tokrow(b, tk) * INC + h * 64 + piece * 8; kv = *(const u32x4*)(rp + C_SK); vv = *(const u32x4*)(rp + C_SV); }
            *(LAS u32x4*)(Ks + kap * 72 + piece * 8) = kv;
            const unsigned vu[4] = {vv.x, vv.y, vv.z, vv.w};
#pragma unroll
            for (int e = 0; e < 4; ++e) { Vt[(piece * 8 + 2 * e) * 72 + slot] = (bf16)(vu[e] & 0xffffu); Vt[(piece * 8 + 2 * e + 1) * 72 + slot] = (bf16)(vu[e] >> 16); }
        }
        __syncthreads();
        if (!wave_done && tk0 < wave_tq_max) {
            f32x4 s[4];
#pragma unroll
            for (int m = 0; m < 4; ++m) {
                s[m] = (f32x4){0.f, 0.f, 0.f, 0.f};
#pragma unroll
                for (int ks = 0; ks < 2; ++ks) {
                    bf16x8 a = *(const LAS bf16x8*)(Ks + (16 * m + ql) * 72 + 32 * ks + 8 * g);
                    s[m] = __builtin_amdgcn_mfma_f32_16x16x32_bf16(a, qF[ks], s[m], 0, 0, 0);
                }
            }
            float z[4][4], sp[4][4]; bool val[4][4];
            unsigned hi[4][2], lo[4][2];
#pragma unroll
            for (int m = 0; m < 4; ++m) {
#pragma unroll
                for (int r = 0; r < 4; ++r) {
                    const int tk = tk0 + 16 * m + 4 * g + r;
                    val[m][r] = (tk >= 0) && (tk < tq);
                    z[m][r] = s[m][r] * 0.125f;
                    sp[m][r] = val[m][r] ? softplusf(z[m][r]) : 0.f;
                }
#pragma unroll
                for (int r2 = 0; r2 < 2; ++r2) {
                    const unsigned hh = pk2(sp[m][2 * r2], sp[m][2 * r2 + 1]);
                    hi[m][r2] = hh;
                    lo[m][r2] = pk2(sp[m][2 * r2] - bflo(hh), sp[m][2 * r2 + 1] - bfhi(hh));
                }
            }
            const bf16x8 hF0 = __builtin_bit_cast(bf16x8, (u32x4){hi[0][0], hi[0][1], hi[1][0], hi[1][1]});
            const bf16x8 hF1 = __builtin_bit_cast(bf16x8, (u32x4){hi[2][0], hi[2][1], hi[3][0], hi[3][1]});
            const bf16x8 lF0 = __builtin_bit_cast(bf16x8, (u32x4){lo[0][0], lo[0][1], lo[1][0], lo[1][1]});
            const bf16x8 lF1 = __builtin_bit_cast(bf16x8, (u32x4){lo[2][0], lo[2][1], lo[3][0], lo[3][1]});
            f32x4 cum[4];
            const f32x4 zero4 = {0.f, 0.f, 0.f, 0.f};
            cum[0] = __builtin_amdgcn_mfma_f32_16x16x32_bf16(FA, hF0, zero4, 0, 0, 0);
            cum[0] = __builtin_amdgcn_mfma_f32_16x16x32_bf16(FA, lF0, cum[0], 0, 0, 0);
            cum[0] = __builtin_amdgcn_mfma_f32_16x16x32_bf16(F1, hF1, cum[0], 0, 0, 0);
            cum[0] = __builtin_amdgcn_mfma_f32_16x16x32_bf16(F1, lF1, cum[0], 0, 0, 0);
            cum[1] = __builtin_amdgcn_mfma_f32_16x16x32_bf16(FB, hF0, zero4, 0, 0, 0);
            cum[1] = __builtin_amdgcn_mfma_f32_16x16x32_bf16(FB, lF0, cum[1], 0, 0, 0);
            cum[1] = __builtin_amdgcn_mfma_f32_16x16x32_bf16(F1, hF1, cum[1], 0, 0, 0);
            cum[1] = __builtin_amdgcn_mfma_f32_16x16x32_bf16(F1, lF1, cum[1], 0, 0, 0);
            cum[2] = __builtin_amdgcn_mfma_f32_16x16x32_bf16(FA, hF1, zero4, 0, 0, 0);
            cum[2] = __builtin_amdgcn_mfma_f32_16x16x32_bf16(FA, lF1, cum[2], 0, 0, 0);
            cum[3] = __builtin_amdgcn_mfma_f32_16x16x32_bf16(FB, hF1, zero4, 0, 0, 0);
            cum[3] = __builtin_amdgcn_mfma_f32_16x16x32_bf16(FB, lF1, cum[3], 0, 0, 0);
            unsigned af[4][2];
#pragma unroll
            for (int m = 0; m < 4; ++m) {
                float av[4];
#pragma unroll
                for (int r = 0; r < 4; ++r) { const float la = (z[m][r] - sp[m][r]) - cum[m][r] - carry; av[r] = val[m][r] ? fast_exp(la) : 0.f; }
                af[m][0] = pk2(av[0], av[1]); af[m][1] = pk2(av[2], av[3]);
            }
            const bf16x8 aF0 = __builtin_bit_cast(bf16x8, (u32x4){af[0][0], af[0][1], af[1][0], af[1][1]});
            const bf16x8 aF1 = __builtin_bit_cast(bf16x8, (u32x4){af[2][0], af[2][1], af[3][0], af[3][1]});
            const float tot = __shfl(cum[0][0] + sp[0][0], ql);
            carry += tot;
#pragma unroll
            for (int d = 0; d < 4; ++d) {
                bf16x8 v0 = *(const LAS bf16x8*)(Vt + (16 * d + ql) * 72 + 8 * g);
                bf16x8 v1 = *(const LAS bf16x8*)(Vt + (16 * d + ql) * 72 + 32 + 8 * g);
                O[d] = __builtin_amdgcn_mfma_f32_16x16x32_bf16(v0, aF0, O[d], 0, 0, 0);
                O[d] = __builtin_amdgcn_mfma_f32_16x16x32_bf16(v1, aF1, O[d], 0, 0, 0);
            }
            if (__all(carry > SB_THR)) wave_done = true;
        }
        const int more = __syncthreads_or((!wave_done && it > 0) ? 1 : 0);
        if (!more) break;
    }
    if (wave_valid && (qb >= 0 || b == 0)) {
        float ss = 0.f;
#pragma unroll
        for (int d = 0; d < 4; ++d) ss += (O[d].x * O[d].x + O[d].y * O[d].y) + (O[d].z * O[d].z + O[d].w * O[d].w);
        ss += __shfl_xor(ss, 16); ss += __shfl_xor(ss, 32);
        const float inv = 1.f / sqrtf(ss * (1.f / 64.f) + 1e-6f);
        bf16* yp = Yo + (size_t)tokrow(b, tq) * DM + 512 + h * 64;
        const float* gp = p.sb_gain + l * 512 + h * 64;
#pragma unroll
        for (int d = 0; d < 4; ++d) {
            const f32x4 gg = *(const f32x4*)(gp + 16 * d + 4 * g);
            const f32x4 v = O[d] * inv * gg;
            u32x2 w; w.x = pk2(v.x, v.y); w.y = pk2(v.z, v.w);
            *(u32x2*)(yp + 16 * d + 4 * g) = w;
        }
    }
}

__device__ __forceinline__ void mix_phase(const Params& p, int l, LAS unsigned char* lds) {
    const int tid = ltid();
    const int G = gridDim.x;
    for (int c = blockIdx.x; c < NB * 8; c += G) rwkv_chain(p, l, c >> 3, c & 7, lds, tid);
    unsigned* ctr = (unsigned*)(p.ws + WS_CTL) + 64 * (l + 1);
    volatile LAS unsigned* qw = (volatile LAS unsigned*)(lds + SB_Q);
    for (;;) {
        __syncthreads();
        if (tid == 0) qw[0] = atomicAdd(ctr, 1u);
        __syncthreads();
        const unsigned u = qw[0];
        if (u >= 2048u + 8u) break;
        if (u < 2048u) { const int qb = 15 - (int)(u >> 7), bh = (int)(u & 127u); sb_unit(p, l, bh >> 3, bh & 7, qb, lds, tid); }
        else sb_unit(p, l, 0, (int)(u - 2048u), -1, lds, tid);
    }
}


template <int N, int K, int ACT>
__device__ __forceinline__ void gemm_call(const bf16* A, const bf16* Bt, bf16* O, LAS unsigned char* lds) {
    pg8::Gemm gm{A, Bt, MR, N, K};
    pg8::StaticOrder S; S.init(MR, N, gridDim.x, blockIdx.x);
    EpiOut E{O, N, ACT};
    pg8::gemm_phase<EpiOut, pg8::StaticOrder, true, true>(lds, gm, S, E);
    { const int t = ltid(); meta_gemm(A, Bt, N, K, O, ACT, blockIdx.x * NWAVES + (t >> 6), gridDim.x * NWAVES, t & 63); }
}

template <int K>
__device__ __forceinline__ void gemm_call_f32(const bf16* A, const bf16* Bt, float* lo, float* hi, LAS unsigned char* lds) {
    pg8::Gemm gm{A, Bt, MR, DM, K};
    pg8::StaticOrder S; S.init(MR, DM, gridDim.x, blockIdx.x);
    EpiF32Split E{lo, hi};
    pg8::gemm_phase<EpiF32Split, pg8::StaticOrder, true, true>(lds, gm, S, E);
    { const int t = ltid(); meta_gemm(A, Bt, DM, K, nullptr, 0, blockIdx.x * NWAVES + (t >> 6), gridDim.x * NWAVES, t & 63, lo, hi); }
}

__global__ void __launch_bounds__(NTHR, 2) trunk_fwd(Params p) {
    extern __shared__ __attribute__((aligned(16))) unsigned char shm[];
    LAS unsigned char* lds = (LAS unsigned char*)shm;
    cg::grid_group grid = cg::this_grid();
#define GSYNC() do { __threadfence(); grid.sync(); __threadfence(); } while (0)
    bf16* RA = (bf16*)(p.ws + WS_RA); bf16* RB = (bf16*)(p.ws + WS_RB);
    float* HM = (float*)(p.ws + WS_HM);
    if (blockIdx.x == 0 && threadIdx.x < 8) ((unsigned*)(p.ws + WS_CTL))[64 * threadIdx.x] = 0u;
    conv_phase(p, lds);
    norm_phase(nullptr, nullptr, nullptr, p.x, p.meta, p.out, HM, p.g_pre_mix, RA);
    GSYNC();
    for (int l = 0; l < NL; ++l) {
        for (int gi = 0; gi < 4; ++gi) {
            if (gi == 1) {
                mix_phase(p, l, lds);
                GSYNC();
            }
            if (gi == 0) gemm_call<INC, DM, 0>(RA, (const bf16*)(p.ws + WS_WIN + l * SZ_WIN), RB, lds);
            else if (gi == 1) gemm_call_f32<DM>(RA, (const bf16*)(p.ws + WS_WOUT + l * SZ_WOUT), (float*)RB, (float*)RB + (size_t)MT * 512, lds);
            else if (gi == 2) gemm_call<DFF, DM, 1>(RA, (const bf16*)(p.ws + WS_WUP + l * SZ_WUP), RB, lds);
            else gemm_call_f32<DFF>(RB, (const bf16*)(p.ws + WS_WDN + l * SZ_WDN), (float*)RA, (float*)(p.ws + WS_T2HI), lds);
            GSYNC();
            if (gi == 1) {
                norm_phase((const float*)RB, (const float*)RB + (size_t)MT * 512, p.g_post_mix + l * DM, l == 0 ? p.x : p.out, l == 0 ? p.meta : HM, p.out, HM, p.g_pre_ffn + l * DM, RA);
                GSYNC();
            } else if (gi == 3) {
                norm_phase((const float*)RA, (const float*)(p.ws + WS_T2HI), p.g_post_ffn + l * DM, p.out, HM, p.out, HM, l + 1 < NL ? p.g_pre_mix + (l + 1) * DM : nullptr, RA);
                if (l + 1 < NL) GSYNC();
            }
        }
    }
}

extern "C" void kernel_launch(void* const* d_in, const int* in_sizes, int n_in, void* d_out, int out_size, void* d_ws, size_t ws_size, hipStream_t stream) {
    static int grid = 0;
    if (grid == 0) {
        if (n_in != 22 || ws_size < WS_END) { fprintf(stderr, "kernel_launch: unexpected n_in %d / ws_size %zu (need %zu)\n", n_in, ws_size, (size_t)WS_END); grid = -1; return; }
        int dev = 0, cus = 0, per_cu = 0;
        hipGetDevice(&dev);
        hipDeviceGetAttribute(&cus, hipDeviceAttributeMultiprocessorCount, dev);
        if (hipFuncSetAttribute((const void*)trunk_fwd, hipFuncAttributeMaxDynamicSharedMemorySize, LDS_BYTES) != hipSuccess) { fprintf(stderr, "kernel_launch: hipFuncSetAttribute failed\n"); grid = -1; return; }
        if (hipOccupancyMaxActiveBlocksPerMultiprocessor(&per_cu, (const void*)trunk_fwd, NTHR, LDS_BYTES) != hipSuccess || per_cu < 1) { fprintf(stderr, "kernel_launch: occupancy query says %d\n", per_cu); per_cu = 1; }
        (void)hipGetLastError();
        grid = cus * per_cu;
        fprintf(stderr, "kernel_launch: grid %d (cus %d x %d)\n", grid, cus, per_cu);
    }
    if (grid < 0) return;
    Params p{};
    const float** f = (const float**)&p;
    for (int i = 0; i < 22; ++i) f[i] = (const float*)d_in[i];
    p.out = (float*)d_out; p.ws = (unsigned char*)d_ws;
    void* args[] = {&p};
    hipError_t e = hipLaunchCooperativeKernel((const void*)trunk_fwd, dim3(grid), dim3(NTHR), args, LDS_BYTES, stream);
    if (e != hipSuccess) fprintf(stderr, "cooperative launch failed: %s (grid %d)\n", hipGetErrorString(e), grid);
}
```

```cpp
#define SCAN_UNROLL 2
#define USE_XCD_BARRIER 1
#include <hip/hip_runtime.h>
#include <hip/hip_cooperative_groups.h>
#include <cstdio>
#include <cstdint>
namespace cg = cooperative_groups;
namespace pg8 {
#define PG8_LAS __attribute__((address_space(3)))
#ifndef PG8_AUX
#define PG8_AUX 2
#endif
typedef unsigned short bf16_t;
typedef short bf16x8 __attribute__((ext_vector_type(8)));
typedef float f32x4 __attribute__((ext_vector_type(4)));
typedef unsigned u32x4 __attribute__((ext_vector_type(4)));
constexpr int BM = 256, BK = 64, HALF = 128, HTB = HALF * BK * 2  , STAGE_BYTES = 8 * HTB, NXCD = 8, WGM = 8;

__host__ __device__ __forceinline__ int lds_byte(int r, int c) { const int st = (r >> 4) * 2 + (c >> 5), rr = r & 15, cc = c & 31, ob = rr * 64 + cc * 2; return st * 1024 + (ob ^ (((ob >> 9) & 1) << 5)); }
__host__ __device__ __forceinline__ void stage_rc(int b, int& R, int& C) { const int st = b / 1024, sb = b % 1024, swz = sb ^ (((sb >> 9) & 1) << 5); R = (st >> 1) * 16 + swz / 64; C = (st & 1) * 32 + (swz % 64) / 2; }
__host__ __device__ __forceinline__ int perm32(int rho) { const int n = rho >> 4, i = rho & 15; return 8 * (i >> 2) + 4 * n + (i & 3); }

struct Unit { int pm, pn; };
struct Gemm { const bf16_t* A; const bf16_t* Bt; int M, N, K; };

struct StaticOrder {
    int nM, nN, nwg, G, c;
    __host__ __device__ void init(int M, int N, int G_, int c_) { nM = M / BM; nN = N / BM; nwg = nM * nN; G = G_; c = c_; }
    __host__ __device__ bool next(int i, Unit& u) const {
        const long L = (long)i * G + c; if (L >= nwg) return false;
        int wgid = (int)L; { const int q = nwg / NXCD, r = nwg % NXCD, xcd = wgid % NXCD, off = wgid / NXCD; wgid = (xcd < r ? xcd * (q + 1) : r * (q + 1) + (xcd - r) * q) + off; }
        const int nig = WGM * nN, gid = wgid / nig, fm = gid * WGM, gsz = (nM - fm) < WGM ? (nM - fm) : WGM;
        u.pm = fm + ((wgid % nig) % gsz); u.pn = (wgid % nig) / gsz; return true;
    }
    __device__ __forceinline__ void a_ready(const Unit&) const {}
    __device__ __forceinline__ void done(const Unit&) const {}
};

__device__ __forceinline__ unsigned cvt_pk_bf16(float lo, float hi) { unsigned r; asm volatile("v_cvt_pk_bf16_f32 %0, %1, %2" : "=v"(r) : "v"(lo), "v"(hi)); return r; }
typedef float f32x2 __attribute__((ext_vector_type(2)));
template <class Epi, class Sched, bool ALIGN_EPI = false, bool SP2 = false>
__device__ __forceinline__ void gemm_phase(PG8_LAS unsigned char* lds, const Gemm g, const Sched& S, const Epi& E) {
    int tid_ = threadIdx.x; asm volatile("" : "+v"(tid_));
    const int tid = tid_, wid = __builtin_amdgcn_readfirstlane(tid >> 6), lane = tid & 63, wr = wid >> 2, wc = wid & 3, fr = lane & 15, fq = lane >> 4;
    const int K = g.K, nt = K / BK;
    unsigned voffA[2], voffB[2];
#pragma unroll
    for (int i = 0; i < 2; ++i) { int R, C; stage_rc(tid * 16 + i * 8192, R, C); const int Rb = Epi::PERM ? ((R & ~31) + perm32(R & 31)) : R;
        voffA[i] = (unsigned)(R * K + C) * 2u; voffB[i] = (unsigned)(Rb * K + C) * 2u; }
    const size_t kstep = (size_t)(BK * 2);
    const size_t hstep = (size_t)HALF * K * 2;
    const size_t tstep = 2 * hstep;
    const unsigned ldsw = (unsigned)wid * 1024u;
    const int aoff = lds_byte(wr * 64 + fr, fq * 8), boff = lds_byte(wc * 32 + fr, fq * 8);
#define PG8_SA(b, h) (((b) * 2 + (h)) * HTB)
#define PG8_SB(b, h) ((4 + (b) * 2 + (h)) * HTB)
#define PG8_STAGE(bufoff, gbase, voff) do { _Pragma("unroll") for (int _i = 0; _i < 2; ++_i) \
        __builtin_amdgcn_global_load_lds((const unsigned*)((const char*)(gbase) + (voff)[_i]), (PG8_LAS unsigned*)(lds + (bufoff) + ldsw + _i * 8192), 16, 0, 0); } while (0)
#define PG8_LDA(dst, b, h) do { _Pragma("unroll") for (int m = 0; m < 4; ++m) _Pragma("unroll") for (int k = 0; k < 2; ++k) dst[m][k] = *(const PG8_LAS bf16x8*)(lds + PG8_SA(b, h) + aoff + m * 2048 + k * 1024); } while (0)
#define PG8_LDB(dst, b, h) do { _Pragma("unroll") for (int n = 0; n < 2; ++n) _Pragma("unroll") for (int k = 0; k < 2; ++k) dst[n][k] = *(const PG8_LAS bf16x8*)(lds + PG8_SB(b, h) + boff + n * 2048 + k * 1024); } while (0)
#define PG8_MMA(ai, bj, At, Bt) do { __builtin_amdgcn_s_setprio(1); _Pragma("unroll") for (int m = 0; m < 4; ++m) _Pragma("unroll") for (int n = 0; n < 2; ++n) _Pragma("unroll") for (int k = 0; k < 2; ++k) \
        acc[ai][bj][m][n] = __builtin_amdgcn_mfma_f32_16x16x32_bf16(Bt[n][k], At[m][k], acc[ai][bj][m][n], 0, 0, 0); __builtin_amdgcn_s_setprio(0); } while (0)
#define PG8_WAIT_V(n) asm volatile("s_waitcnt vmcnt(" #n ")" ::: "memory")
#define PG8_WAIT_L(n) asm volatile("s_waitcnt lgkmcnt(" #n ")" ::: "memory")
#define PG8_BAR __builtin_amdgcn_s_barrier()
#define PG8_SCHED __builtin_amdgcn_sched_barrier(0)
    Unit cur, nxt; int ui = 0;
    if (!S.next(0, cur)) return;
    f32x4 acc[2][2][4][2];
#pragma unroll
    for (int a = 0; a < 2; ++a)
#pragma unroll
        for (int b = 0; b < 2; ++b)
#pragma unroll
            for (int m = 0; m < 4; ++m)
#pragma unroll
                for (int n = 0; n < 2; ++n) acc[a][b][m][n] = (f32x4){0.f, 0.f, 0.f, 0.f};
    bf16x8 At[4][2], B0[2][2], B1[2][2];
    const char* cA = (const char*)g.A + (size_t)cur.pm * tstep; const char* cB = (const char*)g.Bt + (size_t)cur.pn * tstep;
    S.a_ready(cur);
    if constexpr (SP2) {
        PG8_STAGE(PG8_SB(0, 0), cB, voffB); PG8_STAGE(PG8_SB(0, 1), cB + hstep, voffB); PG8_STAGE(PG8_SA(0, 0), cA, voffA); PG8_STAGE(PG8_SA(0, 1), cA + hstep, voffA);
        if (wr == 1) PG8_BAR;
        PG8_WAIT_V(2); PG8_BAR;
        PG8_STAGE(PG8_SB(1, 0), cB + kstep, voffB); PG8_STAGE(PG8_SA(1, 0), cA + kstep, voffA); PG8_STAGE(PG8_SB(1, 1), cB + hstep + kstep, voffB);
        PG8_WAIT_V(6); PG8_BAR;
    } else {
        PG8_STAGE(PG8_SB(0, 0), cB, voffB); PG8_STAGE(PG8_SA(0, 0), cA, voffA); PG8_STAGE(PG8_SB(0, 1), cB + hstep, voffB); PG8_STAGE(PG8_SA(0, 1), cA + hstep, voffA);
        if (wr == 1) PG8_BAR;
        PG8_WAIT_V(4); PG8_BAR;
        PG8_STAGE(PG8_SB(1, 0), cB + kstep, voffB); PG8_STAGE(PG8_SA(1, 0), cA + kstep, voffA); PG8_STAGE(PG8_SB(1, 1), cB + hstep + kstep, voffB);
        PG8_WAIT_V(6); PG8_BAR;
    }
    for (;;) {
        const bool has_next = S.next(ui + 1, nxt);
        const char* nA = has_next ? (const char*)g.A + (size_t)nxt.pm * tstep : cA; const char* nB = has_next ? (const char*)g.Bt + (size_t)nxt.pn * tstep : cB;
        for (int t = 0; t < nt; t += 2) {
            const bool last = (t == nt - 2);
            const char* a1 = cA + (size_t)(t + 1) * kstep;
            const char* a2 = last ? nA : cA + (size_t)(t + 2) * kstep; const char* b2 = last ? nB : cB + (size_t)(t + 2) * kstep;
            const char* a3 = a2 + kstep; const char* b3 = b2 + kstep;
            if (last && has_next) S.a_ready(nxt);
            if constexpr (SP2) {
            PG8_LDB(B0, 0, 0); PG8_LDB(B1, 0, 1); PG8_SCHED; PG8_LDA(At, 0, 0); PG8_STAGE(PG8_SA(1, 1), a1 + hstep, voffA);
            PG8_WAIT_V(8); PG8_WAIT_L(0); PG8_BAR; PG8_MMA(0, 0, At, B0); PG8_MMA(0, 1, At, B1); PG8_BAR; PG8_SCHED;
            PG8_LDA(At, 0, 1); PG8_STAGE(PG8_SB(0, 0), b2, voffB); PG8_STAGE(PG8_SB(0, 1), b2 + hstep, voffB); PG8_STAGE(PG8_SA(0, 0), a2, voffA);
            PG8_WAIT_V(8); PG8_WAIT_L(0); PG8_BAR; PG8_MMA(1, 0, At, B0); PG8_MMA(1, 1, At, B1); PG8_BAR; PG8_SCHED;
            PG8_LDB(B0, 1, 0); PG8_LDB(B1, 1, 1); PG8_SCHED; PG8_LDA(At, 1, 0); PG8_STAGE(PG8_SA(0, 1), a2 + hstep, voffA);
            PG8_WAIT_V(8); PG8_WAIT_L(0); PG8_BAR; PG8_MMA(0, 0, At, B0); PG8_MMA(0, 1, At, B1); PG8_BAR; PG8_SCHED;
            PG8_LDA(At, 1, 1); PG8_STAGE(PG8_SB(1, 0), b3, voffB); PG8_STAGE(PG8_SB(1, 1), b3 + hstep, voffB); PG8_STAGE(PG8_SA(1, 0), a3, voffA);
            PG8_WAIT_V(8); PG8_WAIT_L(0); PG8_BAR; PG8_MMA(1, 0, At, B0); PG8_MMA(1, 1, At, B1); PG8_BAR; PG8_SCHED;
            } else {
            PG8_LDB(B0, 0, 0); PG8_SCHED; PG8_LDA(At, 0, 0); PG8_STAGE(PG8_SA(1, 1), a1 + hstep, voffA);
            PG8_WAIT_L(8); PG8_BAR; PG8_WAIT_L(0); PG8_MMA(0, 0, At, B0); PG8_BAR; PG8_SCHED;
            PG8_LDB(B1, 0, 1); PG8_STAGE(PG8_SB(0, 0), b2, voffB);
            PG8_BAR; PG8_WAIT_L(0); PG8_MMA(0, 1, At, B1); PG8_BAR;
            PG8_LDA(At, 0, 1); PG8_STAGE(PG8_SA(0, 0), a2, voffA);
            PG8_BAR; PG8_WAIT_L(0); PG8_MMA(1, 0, At, B0); PG8_BAR; PG8_SCHED;
            PG8_STAGE(PG8_SB(0, 1), b2 + hstep, voffB);
            PG8_WAIT_V(6); PG8_BAR; PG8_MMA(1, 1, At, B1); PG8_BAR;
            PG8_LDB(B0, 1, 0); PG8_SCHED; PG8_LDA(At, 1, 0); PG8_STAGE(PG8_SA(0, 1), a2 + hstep, voffA);
            PG8_WAIT_L(8); PG8_BAR; PG8_WAIT_L(0); PG8_MMA(0, 0, At, B0); PG8_BAR; PG8_SCHED;
            PG8_LDB(B1, 1, 1); PG8_STAGE(PG8_SB(1, 0), b3, voffB);
            PG8_BAR; PG8_WAIT_L(0); PG8_MMA(0, 1, At, B1); PG8_BAR;
            PG8_LDA(At, 1, 1); PG8_STAGE(PG8_SA(1, 0), a3, voffA);
            PG8_BAR; PG8_WAIT_L(0); PG8_MMA(1, 0, At, B0); PG8_BAR; PG8_SCHED;
            PG8_STAGE(PG8_SB(1, 1), b3 + hstep, voffB);
            PG8_WAIT_V(6); PG8_BAR; PG8_MMA(1, 1, At, B1); PG8_BAR;
            }
        }
        if constexpr (ALIGN_EPI) { if (wr == 0) PG8_BAR; }
        if constexpr (!Epi::AFTER_DRAIN) { E(acc, cur, wr, wc, fr, fq); S.done(cur); }
        if (!has_next) break;
#pragma unroll
        for (int a = 0; a < 2; ++a)
#pragma unroll
            for (int b = 0; b < 2; ++b)
#pragma unroll
                for (int m = 0; m < 4; ++m)
#pragma unroll
                    for (int n = 0; n < 2; ++n) acc[a][b][m][n] = (f32x4){0.f, 0.f, 0.f, 0.f};
        cur = nxt; cA = nA; cB = nB; ++ui;
        if constexpr (ALIGN_EPI) { if (wr == 1) PG8_BAR; }
    }
    PG8_WAIT_V(0);
    if constexpr (!ALIGN_EPI) { if (wr == 0) PG8_BAR; }
    PG8_BAR;
    if constexpr (Epi::AFTER_DRAIN) { E.fused(acc, cur, wr, wc, fr, fq, lds, wid, lane); S.done(cur); }
#undef PG8_SA
#undef PG8_SB
#undef PG8_STAGE
#undef PG8_LDA
#undef PG8_LDB
#undef PG8_MMA
#undef PG8_WAIT_V
#undef PG8_WAIT_L
#undef PG8_BAR
#undef PG8_SCHED
}
}


#define LAS __attribute__((address_space(3)))
typedef unsigned short bf16;
typedef short bf16x8 __attribute__((ext_vector_type(8)));
typedef float f32x4 __attribute__((ext_vector_type(4)));
typedef float f32x2 __attribute__((ext_vector_type(2)));
typedef unsigned u32x4 __attribute__((ext_vector_type(4)));
typedef unsigned u32x2 __attribute__((ext_vector_type(2)));

constexpr int NB = 16, SEQ = 2048, NMETA = 16, TT = SEQ + NMETA, DM = 1024, DFF = 4096, NL = 4;
constexpr int MR = NB * SEQ;
constexpr int MT = MR + NMETA;
constexpr int INC = 3328;
constexpr int C_R = 0, C_K = 512, C_V = 1024, C_DW = 1536, C_DA = 1600, C_DG = 1664, C_Q = 1792, C_SK = 2304, C_SV = 2816;
constexpr int NWAVES = 8, NTHR = 512;
constexpr int LDS_BYTES = 147456;

constexpr size_t WS_CTL = 0;
constexpr size_t WS_BAR = 4096;
constexpr size_t WS_HM = 20480;
constexpr size_t WS_WIN = WS_HM + (size_t)NMETA * DM * 4;
constexpr size_t SZ_WIN = (size_t)INC * DM * 2;
constexpr size_t WS_WOUT = WS_WIN + NL * SZ_WIN;
constexpr size_t SZ_WOUT = (size_t)DM * DM * 2;
constexpr size_t WS_WUP = WS_WOUT + NL * SZ_WOUT;
constexpr size_t SZ_WUP = (size_t)DFF * DM * 2;
constexpr size_t WS_WDN = WS_WUP + NL * SZ_WUP;
constexpr size_t SZ_WDN = SZ_WUP;
constexpr size_t WS_WD = WS_WDN + NL * SZ_WDN;
constexpr size_t SZ_WD = (size_t)512 * 64 * 2;
constexpr size_t WS_WA = WS_WD + NL * SZ_WD;
constexpr size_t WS_WG = WS_WA + NL * SZ_WD;
constexpr size_t SZ_WG = (size_t)512 * 128 * 2;
constexpr size_t WS_RA = WS_WG + NL * SZ_WG;
constexpr size_t SZ_RA = (size_t)MT * DM * 2;
constexpr size_t WS_RB = WS_RA + SZ_RA;
constexpr size_t SZ_RB = (size_t)MT * DFF * 2;
constexpr size_t WS_T2HI = WS_RB + SZ_RB;
constexpr size_t WS_END = WS_T2HI + (size_t)MT * 512 * 4;

struct Params {
    const float* x; const float* meta; const float* g_pre_mix; const float* g_post_mix; const float* g_pre_ffn; const float* g_post_ffn;
    const float* w_in; const float* mu; const float* w_decay_up; const float* decay_bias; const float* w_a_up; const float* a_bias; const float* w_g_up;
    const float* k_k; const float* k_a; const float* r_k; const float* lnx_gain; const float* lnx_bias; const float* sb_gain;
    const float* w_out; const float* w_up; const float* w_dn;
    float* out; unsigned char* ws;
};

typedef const __attribute__((address_space(4))) Params* KParams;
__device__ __forceinline__ KParams kargs() { KParams k = (KParams)__builtin_amdgcn_kernarg_segment_ptr(); asm volatile("" : "+s"(k)); return k; }
__device__ __forceinline__ int ltid() { int t = threadIdx.x; asm volatile("" : "+v"(t)); return t; }
__device__ __forceinline__ unsigned f2bf(float f) { unsigned u = __builtin_bit_cast(unsigned, f); return (u + 0x7fffu + ((u >> 16) & 1u)) >> 16; }
__device__ __forceinline__ unsigned pk2(float lo, float hi) { unsigned r; asm volatile("v_cvt_pk_bf16_f32 %0, %1, %2" : "=v"(r) : "v"(lo), "v"(hi)); return r; }
__device__ __forceinline__ float bflo(unsigned u) { return __builtin_bit_cast(float, u << 16); }
__device__ __forceinline__ float bfhi(unsigned u) { return __builtin_bit_cast(float, u & 0xffff0000u); }
__device__ __forceinline__ int tokrow(int b, int t) { return t < NMETA ? MR + t : b * SEQ + (t - NMETA); }
__device__ __forceinline__ float wave_sum(float v) {
#pragma unroll
    for (int o = 1; o < 64; o <<= 1) v += __shfl_xor(v, o);
    return v;
}
__device__ __forceinline__ float sum16(float v) {
#pragma unroll
    for (int o = 1; o < 16; o <<= 1) v += __shfl_xor(v, o);
    return v;
}
template <int CTRL> __device__ __forceinline__ float dppf(float x) {
    return __builtin_bit_cast(float, __builtin_amdgcn_update_dpp(0, __builtin_bit_cast(int, x), CTRL, 0xF, 0xF, true));
}
__device__ __forceinline__ float sum8(float v) {
    v += dppf<0xB1>(v);
    v += dppf<0x4E>(v);
    v += dppf<0x141>(v);
    return v;
}
__device__ __forceinline__ float fast_exp(float x) { return __builtin_amdgcn_exp2f(x * 1.4426950408889634f); }
__device__ __forceinline__ float fast_log(float x) { return __builtin_amdgcn_logf(x) * 0.6931471805599453f; }
__device__ __forceinline__ float softplusf(float z) { return fmaxf(z, 0.f) + fast_log(1.f + fast_exp(-fabsf(z))); }
__device__ __forceinline__ float sigmoidf_(float z) { return __builtin_amdgcn_rcpf(1.f + fast_exp(-z)); }

template <class T> __device__ __forceinline__ T ldnt(const void* p) { return __builtin_nontemporal_load((const T*)p); }

struct EpiOut {
    static constexpr bool PERM = true, AFTER_DRAIN = false;
    bf16* O; int ldc; int act;
    __device__ __forceinline__ void operator()(const f32x4 (&acc)[2][2][4][2], const pg8::Unit& u, int wr, int wc, int fr, int fq) const {
        const int row0 = u.pm * 256 + wr * 64 + fr, col0 = u.pn * 256 + wc * 32 + 8 * fq;
#pragma unroll
        for (int ai = 0; ai < 2; ++ai)
#pragma unroll
            for (int m = 0; m < 4; ++m) { bf16* rowp = O + (size_t)(row0 + ai * 128 + m * 16) * ldc + col0;
#pragma unroll
                for (int bj = 0; bj < 2; ++bj) { f32x4 v0 = acc[ai][bj][m][0], v1 = acc[ai][bj][m][1];
                    if (act) {
#pragma unroll
                        for (int e = 0; e < 4; ++e) { float a = fmaxf(v0[e], 0.f), b = fmaxf(v1[e], 0.f); v0[e] = a * a; v1[e] = b * b; } }
                    u32x4 w; w.x = pk2(v0[0], v0[1]); w.y = pk2(v0[2], v0[3]); w.z = pk2(v1[0], v1[1]); w.w = pk2(v1[2], v1[3]);
                    *(u32x4*)(rowp + bj * 128) = w; } }
    }
};

struct EpiF32Split {
    static constexpr bool PERM = true, AFTER_DRAIN = false;
    float* lo; float* hi;
    __device__ __forceinline__ void operator()(const f32x4 (&acc)[2][2][4][2], const pg8::Unit& u, int wr, int wc, int fr, int fq) const {
        const int row0 = u.pm * 256 + wr * 64 + fr, col0 = (u.pn & 1) * 256 + wc * 32 + 8 * fq;
        float* base = (u.pn < 2) ? lo : hi;
#pragma unroll
        for (int ai = 0; ai < 2; ++ai)
#pragma unroll
            for (int m = 0; m < 4; ++m) { float* rowp = base + (size_t)(row0 + ai * 128 + m * 16) * 512 + col0;
#pragma unroll
                for (int bj = 0; bj < 2; ++bj) { *(f32x4*)(rowp + bj * 128) = acc[ai][bj][m][0]; *(f32x4*)(rowp + bj * 128 + 4) = acc[ai][bj][m][1]; } }
    }
};

__device__ __forceinline__ void meta_gemm(const bf16* A, const bf16* Bt, int N, int K, bf16* O, int act, int gw, int ngw, int lane, float* flo = nullptr, float* fhi = nullptr) {
    const int i = lane & 15, g = lane >> 4;
    for (int task = gw; task < N / 16; task += ngw) {
        const int n0 = task * 16;
        const bf16* ap = Bt + (size_t)(n0 + i) * K + 8 * g;
        const bf16* bp = A + (size_t)(MR + i) * K + 8 * g;
        f32x4 acc = {0.f, 0.f, 0.f, 0.f};
#pragma unroll 4
        for (int k0 = 0; k0 < K; k0 += 32) {
            bf16x8 a = ldnt<bf16x8>(ap + k0), b = ldnt<bf16x8>(bp + k0);
            acc = __builtin_amdgcn_mfma_f32_16x16x32_bf16(a, b, acc, 0, 0, 0);
        }
        if (act) {
#pragma unroll
            for (int e = 0; e < 4; ++e) { float a = fmaxf(acc[e], 0.f); acc[e] = a * a; } }
        if (flo) { float* base = (n0 < 512) ? flo : fhi; *(f32x4*)(base + (size_t)(MR + i) * 512 + (n0 & 511) + 4 * g) = acc; }
        else { u32x2 w; w.x = pk2(acc[0], acc[1]); w.y = pk2(acc[2], acc[3]);
        *(u32x2*)(O + (size_t)(MR + i) * N + n0 + 4 * g) = w; }
    }
}

__device__ __forceinline__ void transpose_item(const float* W, int K, int N, bf16* WT, LAS float* scr, int item, int lane) {
    const int nblk = N / 32, kb = item / nblk, nb = item % nblk, k0 = 64 * kb, n0 = 32 * nb;
#pragma unroll 8
    for (int i = 0; i < 32; ++i) { const int kk = 2 * i + (lane >> 5); scr[kk * 33 + (lane & 31)] = W[(size_t)(k0 + kk) * N + n0 + (lane & 31)]; }
    asm volatile("s_waitcnt lgkmcnt(0)" ::: "memory");
    const int c = lane & 7;
#pragma unroll
    for (int j = 0; j < 4; ++j) { const int n = (lane >> 3) + 8 * j; const LAS float* s = scr + (8 * c) * 33 + n;
        u32x4 o; o.x = pk2(s[0 * 33], s[1 * 33]); o.y = pk2(s[2 * 33], s[3 * 33]); o.z = pk2(s[4 * 33], s[5 * 33]); o.w = pk2(s[6 * 33], s[7 * 33]);
        *(u32x4*)(WT + (size_t)(n0 + n) * K + k0 + 8 * c) = o; }
    asm volatile("s_waitcnt lgkmcnt(0)" ::: "memory");
}
__device__ __forceinline__ void conv_phase(const Params& p, LAS unsigned char* lds) {
    const int t_ = ltid(), lane = t_ & 63, wave = t_ >> 6, gw = blockIdx.x * NWAVES + wave, ngw = gridDim.x * NWAVES;
    LAS float* scr = (LAS float*)(lds + wave * 16384);
    constexpr int I_IN = 16 * 104, I_OUT = 16 * 32, I_UP = 16 * 128, I_DN = 64 * 32, I_D = 16, I_A = 16, I_G = 32;
    constexpr int PER = I_IN + I_OUT + I_UP + I_DN + I_D + I_A + I_G;
    for (int it = gw; it < NL * PER; it += ngw) {
        const int l = it / PER; int r = it % PER;
        if (r < I_IN) { transpose_item(p.w_in + (size_t)l * DM * INC, DM, INC, (bf16*)(p.ws + WS_WIN + l * SZ_WIN), scr, r, lane); continue; } r -= I_IN;
        if (r < I_OUT) { transpose_item(p.w_out + (size_t)l * DM * DM, DM, DM, (bf16*)(p.ws + WS_WOUT + l * SZ_WOUT), scr, r, lane); continue; } r -= I_OUT;
        if (r < I_UP) { transpose_item(p.w_up + (size_t)l * DM * DFF, DM, DFF, (bf16*)(p.ws + WS_WUP + l * SZ_WUP), scr, r, lane); continue; } r -= I_UP;
        if (r < I_DN) { transpose_item(p.w_dn + (size_t)l * DFF * DM, DFF, DM, (bf16*)(p.ws + WS_WDN + l * SZ_WDN), scr, r, lane); continue; } r -= I_DN;
        if (r < I_D) { transpose_item(p.w_decay_up + (size_t)l * 64 * 512, 64, 512, (bf16*)(p.ws + WS_WD + l * SZ_WD), scr, r, lane); continue; } r -= I_D;
        if (r < I_A) { transpose_item(p.w_a_up + (size_t)l * 64 * 512, 64, 512, (bf16*)(p.ws + WS_WA + l * SZ_WD), scr, r, lane); continue; } r -= I_A;
        transpose_item(p.w_g_up + (size_t)l * 128 * 512, 128, 512, (bf16*)(p.ws + WS_WG + l * SZ_WG), scr, r, lane);
    }
}

__device__ __forceinline__ void norm_phase(const float* T, const float* Thi, const float* g1, const float* hin_real, const float* hin_meta, float* hout_real, float* hout_meta,
                                           const float* g2, bf16* xn) {
    const int t_ = ltid(), lane = t_ & 63, gw = blockIdx.x * NWAVES + (t_ >> 6), ngw = gridDim.x * NWAVES;
    for (int m = gw; m < MT; m += ngw) {
        const float* hi = m < MR ? hin_real + (size_t)m * DM : hin_meta + (size_t)(m - MR) * DM;
        float* ho = m < MR ? hout_real + (size_t)m * DM : hout_meta + (size_t)(m - MR) * DM;
        f32x4 h[4];
#pragma unroll
        for (int j = 0; j < 4; ++j) h[j] = *((const f32x4*)hi + lane + 64 * j);
        if (T) {
            f32x4 t[4]; float ss = 0.f;
#pragma unroll
            for (int j = 0; j < 4; ++j) { t[j] = *((const f32x4*)((j < 2 ? T : Thi) + (size_t)m * 512) + lane + 64 * (j & 1));
                ss += (t[j].x * t[j].x + t[j].y * t[j].y) + (t[j].z * t[j].z + t[j].w * t[j].w); }
            const float r1 = 1.f / sqrtf(wave_sum(ss) * (1.f / DM) + 1e-6f);
#pragma unroll
            for (int j = 0; j < 4; ++j) { f32x4 gg = *((const f32x4*)g1 + lane + 64 * j); h[j] = h[j] + t[j] * r1 * gg; *((f32x4*)ho + lane + 64 * j) = h[j]; }
        }
        if (g2) {
            float ss = 0.f;
#pragma unroll
            for (int j = 0; j < 4; ++j) ss += (h[j].x * h[j].x + h[j].y * h[j].y) + (h[j].z * h[j].z + h[j].w * h[j].w);
            const float r2 = 1.f / sqrtf(wave_sum(ss) * (1.f / DM) + 1e-6f);
            u32x2* o = (u32x2*)(xn + (size_t)m * DM) + lane;
#pragma unroll
            for (int j = 0; j < 4; ++j) { f32x4 gg = *((const f32x4*)g2 + lane + 64 * j); f32x4 v = h[j] * r2 * gg;
                u32x2 w; w.x = pk2(v.x, v.y); w.y = pk2(v.z, v.w); o[64 * j] = w; }
        }
    }
}

constexpr int RW_CH = 32;
constexpr int RW_R = 0, RW_W = 8192, RW_K = 16384, RW_V = 24576, RW_KKN = 32768, RW_B = 40960, RW_Y = 49152, RW_G = 57344;
constexpr int RW_TD = 65536, RW_DA = 70144, RW_SG = 74752, RW_BON = 83456;

__device__ __forceinline__ void rwkv_chain(const Params& p, int l, int b, int h, LAS unsigned char* lds, int tid) {
    const int wave = tid >> 6, lane = tid & 63;
    const bf16* P = (const bf16*)(p.ws + WS_RB);
    bf16* Yo = (bf16*)(p.ws + WS_RA);
    LAS float* R = (LAS float*)(lds + RW_R); LAS float* W = (LAS float*)(lds + RW_W); LAS float* Kx = (LAS float*)(lds + RW_K); LAS float* V = (LAS float*)(lds + RW_V);
    LAS float* KKN = (LAS float*)(lds + RW_KKN); LAS float* BV = (LAS float*)(lds + RW_B); LAS float* Y = (LAS float*)(lds + RW_Y); LAS float* G = (LAS float*)(lds + RW_G);
    LAS bf16* TD = (LAS bf16*)(lds + RW_TD); LAS bf16* DA = (LAS bf16*)(lds + RW_DA); LAS bf16* SG = (LAS bf16*)(lds + RW_SG); LAS float* BON = (LAS float*)(lds + RW_BON);
    const float* mu = p.mu + (size_t)l * 1792;
    const int mt = wave & 1, nt = wave >> 1, fi = lane & 15, fg = lane >> 4;
    bf16x8 wdF[2], waF[2], wgF[4];
    {
        const bf16* wd = (const bf16*)(p.ws + WS_WD + l * SZ_WD) + (size_t)(h * 64 + nt * 16 + fi) * 64 + 8 * fg;
        const bf16* wa = (const bf16*)(p.ws + WS_WA + l * SZ_WD) + (size_t)(h * 64 + nt * 16 + fi) * 64 + 8 * fg;
        const bf16* wg = (const bf16*)(p.ws + WS_WG + l * SZ_WG) + (size_t)(h * 64 + nt * 16 + fi) * 128 + 8 * fg;
        wdF[0] = *(const bf16x8*)wd; wdF[1] = *(const bf16x8*)(wd + 32);
        waF[0] = *(const bf16x8*)wa; waF[1] = *(const bf16x8*)(wa + 32);
#pragma unroll
        for (int k = 0; k < 4; ++k) wgF[k] = *(const bf16x8*)(wg + 32 * k);
    }
    const int cB = h * 64 + nt * 16 + fi;
    const float dbias = p.decay_bias[l * 512 + cB], abias = p.a_bias[l * 512 + cB];
    const int tokC = tid >> 4, ch4 = (tid & 15) * 4, cC = h * 64 + ch4;
    const f32x4 kkv = *(const f32x4*)(p.k_k + l * 512 + cC), kav = *(const f32x4*)(p.k_a + l * 512 + cC), rkv = *(const f32x4*)(p.r_k + l * 512 + cC);
    const f32x4 lgv = *(const f32x4*)(p.lnx_gain + l * 512 + cC), lbv = *(const f32x4*)(p.lnx_bias + l * 512 + cC);
    const int vrow = (tid >> 3) & 31, kq = tid & 7;
    f32x2 S[2][4];
#pragma unroll
    for (int q = 0; q < 2; ++q)
#pragma unroll
        for (int j = 0; j < 4; ++j) S[q][j] = (f32x2){0.f, 0.f};

    u32x4 pc[4], pp[4];
    LAS float* MU = (LAS float*)(lds + 83968);
    if (tid < 448) { const int gi = tid >> 3; const int col = gi < 24 ? (gi >> 3) * 512 + h * 64 + (gi & 7) * 8 : C_DW + (gi - 24) * 8; MU[tid] = mu[col + (tid & 7)]; }
#pragma unroll
    for (int k = 0; k < 4; ++k) { pc[k] = (u32x4){0u, 0u, 0u, 0u}; pp[k] = pc[k]; }
#define RW_IK(k) (((tid + NTHR * (k)) * 4682) >> 18)
#define RW_GIK(k) ((tid + NTHR * (k)) - 56 * RW_IK(k))
#define RW_COL(gi) ((gi) < 24 ? ((gi) >> 3) * 512 + h * 64 + ((gi) & 7) * 8 : C_DW + ((gi) - 24) * 8)
#define RW_ISSUE(T0, NT) do { _Pragma("unroll") for (int k = 0; k < 4; ++k) { if (tid + NTHR * k < (NT) * 56) { const int t_ = (T0) + RW_IK(k); const int c_ = RW_COL(RW_GIK(k)); \
        pc[k] = ldnt<u32x4>(P + (size_t)tokrow(b, t_) * INC + c_); pp[k] = (u32x4){0u, 0u, 0u, 0u}; \
        if (t_ > 0) pp[k] = ldnt<u32x4>(P + (size_t)tokrow(b, t_ - 1) * INC + c_); } } } while (0)
    RW_ISSUE(0, NMETA);
    __syncthreads();
    for (int t0 = 0; t0 < TT; ) {
        const int ntok = (t0 == 0) ? NMETA : RW_CH;
#pragma unroll
        for (int k = 0; k < 4; ++k) {
            if (tid + NTHR * k < ntok * 56) {
                const int i = RW_IK(k), gi = RW_GIK(k);
                float xv[8];
                {
                    const unsigned cu[4] = {pc[k].x, pc[k].y, pc[k].z, pc[k].w}, pu[4] = {pp[k].x, pp[k].y, pp[k].z, pp[k].w};
                    const f32x4 ma = *(const LAS f32x4*)(MU + gi * 8), mb = *(const LAS f32x4*)(MU + gi * 8 + 4);
                    const float mm[8] = {ma.x, ma.y, ma.z, ma.w, mb.x, mb.y, mb.z, mb.w};
#pragma unroll
                    for (int e = 0; e < 4; ++e) { float c0 = bflo(cu[e]), c1 = bfhi(cu[e]), q0 = bflo(pu[e]), q1 = bfhi(pu[e]);
                        xv[2 * e] = c0 + (q0 - c0) * mm[2 * e]; xv[2 * e + 1] = c1 + (q1 - c1) * mm[2 * e + 1]; }
                }
                if (gi < 24) {
                    LAS float* dst = (gi < 8 ? R : (gi < 16 ? Kx : V)) + i * 64 + (gi & 7) * 8;
                    *(LAS f32x4*)dst = (f32x4){xv[0], xv[1], xv[2], xv[3]}; *(LAS f32x4*)(dst + 4) = (f32x4){xv[4], xv[5], xv[6], xv[7]};
                } else if (gi < 32) {
                    float tv[8];
#pragma unroll
                    for (int e = 0; e < 8; ++e) tv[e] = 1.f - 2.f * __builtin_amdgcn_rcpf(fast_exp(2.f * xv[e]) + 1.f);
                    u32x4 w; w.x = pk2(tv[0], tv[1]); w.y = pk2(tv[2], tv[3]); w.z = pk2(tv[4], tv[5]); w.w = pk2(tv[6], tv[7]);
                    *(LAS u32x4*)(TD + i * 72 + (gi - 24) * 8) = w;
                } else if (gi < 40) {
                    u32x4 w; w.x = pk2(xv[0], xv[1]); w.y = pk2(xv[2], xv[3]); w.z = pk2(xv[4], xv[5]); w.w = pk2(xv[6], xv[7]);
                    *(LAS u32x4*)(DA + i * 72 + (gi - 32) * 8) = w;
                } else {
                    float tv[8];
#pragma unroll
                    for (int e = 0; e < 8; ++e) tv[e] = sigmoidf_(xv[e]);
                    u32x4 w; w.x = pk2(tv[0], tv[1]); w.y = pk2(tv[2], tv[3]); w.z = pk2(tv[4], tv[5]); w.w = pk2(tv[6], tv[7]);
                    *(LAS u32x4*)(SG + i * 136 + (gi - 40) * 8) = w;
                }
            }
        }
        __syncthreads();
#ifndef ISSUE_LATE
        if (t0 + ntok < TT) RW_ISSUE(t0 + ntok, RW_CH);
#endif
        {
            f32x4 ad = {0.f, 0.f, 0.f, 0.f}, aa = ad, ag = ad;
#pragma unroll
            for (int ks = 0; ks < 2; ++ks) {
                bf16x8 fa = *(const LAS bf16x8*)(TD + (16 * mt + fi) * 72 + 32 * ks + 8 * fg);
                ad = __builtin_amdgcn_mfma_f32_16x16x32_bf16(fa, wdF[ks], ad, 0, 0, 0);
                bf16x8 fb = *(const LAS bf16x8*)(DA + (16 * mt + fi) * 72 + 32 * ks + 8 * fg);
                aa = __builtin_amdgcn_mfma_f32_16x16x32_bf16(fb, waF[ks], aa, 0, 0, 0);
            }
#pragma unroll
            for (int ks = 0; ks < 4; ++ks) {
                bf16x8 fc = *(const LAS bf16x8*)(SG + (16 * mt + fi) * 136 + 32 * ks + 8 * fg);
                ag = __builtin_amdgcn_mfma_f32_16x16x32_bf16(fc, wgF[ks], ag, 0, 0, 0);
            }
#pragma unroll
            for (int r = 0; r < 4; ++r) {
                const int tok = 16 * mt + 4 * fg + r, o = tok * 64 + nt * 16 + fi;
                const float xd = dbias + ad[r];
                const float wlog = -softplusf(-xd) - 0.5f;
                W[o] = fast_exp(-fast_exp(wlog));
                BV[o] = sigmoidf_(abias + aa[r]);
                G[o] = ag[r];
            }
        }
        __syncthreads();
        {
            const int o = tokC * 64 + ch4;
            const f32x4 k = *(const LAS f32x4*)(Kx + o), a = *(const LAS f32x4*)(BV + o), r = *(const LAS f32x4*)(R + o);
            f32x4 kk = k * kkv;
            const float ss = sum16((kk.x * kk.x + kk.y * kk.y) + (kk.z * kk.z + kk.w * kk.w));
            const float inv = 1.f / sqrtf(ss + 1e-12f);
            kk = kk * inv;
            const f32x4 km = k * (1.f + (a - 1.f) * kav);
            const f32x4 bb = r * km * rkv;
            const float bon = sum16((bb.x + bb.y) + (bb.z + bb.w));
            *(LAS f32x4*)(KKN + o) = -kk; *(LAS f32x4*)(BV + o) = kk * a; *(LAS f32x4*)(Kx + o) = km;
            if ((tid & 15) == 0) BON[tokC] = bon;
        }
        __syncthreads();
#ifdef ISSUE_LATE
        if (t0 + ntok < TT) RW_ISSUE(t0 + ntok, RW_CH);
#endif
        if (tid < 256) {
#ifndef SCAN_UNROLL
#define SCAN_UNROLL 2
#endif
#pragma unroll SCAN_UNROLL
            for (int i = 0; i < ntok; ++i) {
                const int o = i * 64 + kq * 8;
                const f32x4 n0 = *(const LAS f32x4*)(KKN + o), n1 = *(const LAS f32x4*)(KKN + o + 4);
                const f32x4 w0 = *(const LAS f32x4*)(W + o), w1 = *(const LAS f32x4*)(W + o + 4);
                const f32x4 b0 = *(const LAS f32x4*)(BV + o), b1 = *(const LAS f32x4*)(BV + o + 4);
                const f32x4 k0 = *(const LAS f32x4*)(Kx + o), k1 = *(const LAS f32x4*)(Kx + o + 4);
                const f32x4 r0 = *(const LAS f32x4*)(R + o), r1 = *(const LAS f32x4*)(R + o + 4);
                const f32x2 vpair = *(const LAS f32x2*)(V + i * 64 + 2 * vrow);
                const f32x2 nn[4] = {{n0.x, n0.y}, {n0.z, n0.w}, {n1.x, n1.y}, {n1.z, n1.w}};
                const f32x2 ww[4] = {{w0.x, w0.y}, {w0.z, w0.w}, {w1.x, w1.y}, {w1.z, w1.w}};
                const f32x2 bb[4] = {{b0.x, b0.y}, {b0.z, b0.w}, {b1.x, b1.y}, {b1.z, b1.w}};
                const f32x2 kk2[4] = {{k0.x, k0.y}, {k0.z, k0.w}, {k1.x, k1.y}, {k1.z, k1.w}};
                const f32x2 rr2[4] = {{r0.x, r0.y}, {r0.z, r0.w}, {r1.x, r1.y}, {r1.z, r1.w}};
                float sa[2], yy[2];
#pragma unroll
                for (int q = 0; q < 2; ++q) {
                    f32x2 s2 = S[q][0] * nn[0];
                    s2 = __builtin_elementwise_fma(S[q][1], nn[1], s2);
                    f32x2 s3 = S[q][2] * nn[2];
                    s3 = __builtin_elementwise_fma(S[q][3], nn[3], s3);
                    s2 = s2 + s3;
                    sa[q] = s2.x + s2.y;
                }
                sa[0] += dppf<0xB1>(sa[0]); sa[1] += dppf<0xB1>(sa[1]);
                sa[0] += dppf<0x4E>(sa[0]); sa[1] += dppf<0x4E>(sa[1]);
                sa[0] += dppf<0x141>(sa[0]); sa[1] += dppf<0x141>(sa[1]);
#pragma unroll
                for (int q = 0; q < 2; ++q) {
                    const f32x2 sa2 = {sa[q], sa[q]}, vv2 = {vpair[q], vpair[q]};
#pragma unroll
                    for (int j = 0; j < 4; ++j) S[q][j] = __builtin_elementwise_fma(S[q][j], ww[j], __builtin_elementwise_fma(sa2, bb[j], vv2 * kk2[j]));
                    f32x2 y2 = S[q][0] * rr2[0];
                    y2 = __builtin_elementwise_fma(S[q][1], rr2[1], y2);
                    f32x2 y3 = S[q][2] * rr2[2];
                    y3 = __builtin_elementwise_fma(S[q][3], rr2[3], y3);
                    y2 = y2 + y3;
                    yy[q] = y2.x + y2.y;
                }
                yy[0] += dppf<0xB1>(yy[0]); yy[1] += dppf<0xB1>(yy[1]);
                yy[0] += dppf<0x4E>(yy[0]); yy[1] += dppf<0x4E>(yy[1]);
                yy[0] += dppf<0x141>(yy[0]); yy[1] += dppf<0x141>(yy[1]);
                if (kq == 0) *(LAS f32x2*)(Y + i * 64 + 2 * vrow) = (f32x2){yy[0], yy[1]};
            }
        }
        __syncthreads();
        if (tokC < ntok && (t0 > 0 || b == 0)) {
            const int o = tokC * 64 + ch4;
            const f32x4 y = *(const LAS f32x4*)(Y + o);
            const float mean = sum16((y.x + y.y) + (y.z + y.w)) * (1.f / 64.f);
            const f32x4 d = y - mean;
            const float var = sum16((d.x * d.x + d.y * d.y) + (d.z * d.z + d.w * d.w)) * (1.f / 64.f);
            const float rs = 1.f / sqrtf(var + 6.4e-4f);
            f32x4 yn = d * rs * lgv + lbv;
            const f32x4 vv = *(const LAS f32x4*)(V + o), gg = *(const LAS f32x4*)(G + o);
            yn = (yn + BON[tokC] * vv) * gg;
            u32x2 w; w.x = pk2(yn.x, yn.y); w.y = pk2(yn.z, yn.w);
            *(u32x2*)(Yo + (size_t)tokrow(b, t0 + tokC) * DM + cC) = w;
        } else if (tokC < ntok) {
        }
        __syncthreads();
        t0 += ntok;
    }
}

constexpr int SB_KS = 0, SB_VT = 9216, SB_Q = 18432;
constexpr float SB_THR = 90.f;

__device__ __forceinline__ void sb_unit(const Params& p, int l, int b, int h, int qb, LAS unsigned char* lds, int tid) {
    const int wave = tid >> 6, lane = tid & 63, ql = lane & 15, g = lane >> 4;
    const bf16* P = (const bf16*)(p.ws + WS_RB);
    bf16* Yo = (bf16*)(p.ws + WS_RA);
    LAS bf16* Ks = (LAS bf16*)(lds + SB_KS); LAS bf16* Vt = (LAS bf16*)(lds + SB_VT);
    const int tq = (qb < 0 ? 0 : NMETA + 128 * qb) + 16 * wave + ql;
    const bool wave_valid = (qb >= 0) || (wave == 0);
    const int tqc = wave_valid ? tq : 0;
    bf16x8 qF[2];
    {
        const bf16* qp = P + (size_t)tokrow(b, tqc) * INC + C_Q + h * 64 + 8 * g;
        qF[0] = ldnt<bf16x8>(qp); qF[1] = ldnt<bf16x8>(qp + 32);
    }
    unsigned P01, P23; const unsigned ONES = 0x3F803F80u;
    { const unsigned p0 = (4 * g + 0 > ql) ? 0x3F80u : 0u, p1 = (4 * g + 1 > ql) ? 0x3F80u : 0u, p2 = (4 * g + 2 > ql) ? 0x3F80u : 0u, p3 = (4 * g + 3 > ql) ? 0x3F80u : 0u;
      P01 = p0 | (p1 << 16); P23 = p2 | (p3 << 16); }
    const bf16x8 FA = __builtin_bit_cast(bf16x8, (u32x4){P01, P23, ONES, ONES});
    const bf16x8 FB = __builtin_bit_cast(bf16x8, (u32x4){0u, 0u, P01, P23});
    const bf16x8 F1 = __builtin_bit_cast(bf16x8, (u32x4){ONES, ONES, ONES, ONES});
    f32x4 O[4];
#pragma unroll
    for (int d = 0; d < 4; ++d) O[d] = (f32x4){0.f, 0.f, 0.f, 0.f};
    float carry = 0.f;
    const int wave_tq_max = (qb < 0 ? 0 : NMETA + 128 * qb) + 16 * wave + 15;
    const int i_hi = qb < 0 ? 0 : 2 * qb + 2;
    const int kap = tid >> 3, piece = tid & 7;
    const int slot = (kap >> 5) * 32 + ((kap >> 2) & 3) * 8 + ((kap >> 4) & 1) * 4 + (kap & 3);
    bool wave_done = !wave_valid;
    volatile LAS unsigned* orw = (volatile LAS unsigned*)(lds + SB_Q + 16);
    if (tid < 2) orw[tid] = 0u;
    int nit = 0;
    for (int it = i_hi; it >= 0; --it, ++nit) {
        const int tk0 = NMETA + 64 * (it - 1);
        {
            const int tk = tk0 + kap;
            u32x4 kv = {0u, 0u, 0u, 0u}, vv = kv;
            if (tk >= 0) { const bf16* rp = P + (size_t)tokrow(b, tk) * INC + h * 64 + piece * 8; kv = ldnt<u32x4>(rp + C_SK); vv = ldnt<u32x4>(rp + C_SV); }
            *(LAS u32x4*)(Ks + kap * 72 + piece * 8) = kv;
            const unsigned vu[4] = {vv.x, vv.y, vv.z, vv.w};
#pragma unroll
            for (int e = 0; e < 4; ++e) { Vt[(piece * 8 + 2 * e) * 72 + slot] = (bf16)(vu[e] & 0xffffu); Vt[(piece * 8 + 2 * e + 1) * 72 + slot] = (bf16)(vu[e] >> 16); }
        }
        __syncthreads();
        if (!wave_done && tk0 < wave_tq_max) {
            f32x4 s[4];
#pragma unroll
            for (int m = 0; m < 4; ++m) {
                s[m] = (f32x4){0.f, 0.f, 0.f, 0.f};
#pragma unroll
                for (int ks = 0; ks < 2; ++ks) {
                    bf16x8 a = *(const LAS bf16x8*)(Ks + (16 * m + ql) * 72 + 32 * ks + 8 * g);
                    s[m] = __builtin_amdgcn_mfma_f32_16x16x32_bf16(a, qF[ks], s[m], 0, 0, 0);
                }
            }
            float z[4][4], sp[4][4]; bool val[4][4];
            unsigned hi[4][2], lo[4][2];
#pragma unroll
            for (int m = 0; m < 4; ++m) {
#pragma unroll
                for (int r = 0; r < 4; ++r) {
                    const int tk = tk0 + 16 * m + 4 * g + r;
                    val[m][r] = (tk >= 0) && (tk < tq);
                    z[m][r] = s[m][r] * 0.125f;
                    sp[m][r] = val[m][r] ? softplusf(z[m][r]) : 0.f;
                }
#pragma unroll
                for (int r2 = 0; r2 < 2; ++r2) {
                    const unsigned hh = pk2(sp[m][2 * r2], sp[m][2 * r2 + 1]);
                    hi[m][r2] = hh;
                    lo[m][r2] = pk2(sp[m][2 * r2] - bflo(hh), sp[m][2 * r2 + 1] - bfhi(hh));
                }
            }
            const bf16x8 hF0 = __builtin_bit_cast(bf16x8, (u32x4){hi[0][0], hi[0][1], hi[1][0], hi[1][1]});
            const bf16x8 hF1 = __builtin_bit_cast(bf16x8, (u32x4){hi[2][0], hi[2][1], hi[3][0], hi[3][1]});
            const bf16x8 lF0 = __builtin_bit_cast(bf16x8, (u32x4){lo[0][0], lo[0][1], lo[1][0], lo[1][1]});
            const bf16x8 lF1 = __builtin_bit_cast(bf16x8, (u32x4){lo[2][0], lo[2][1], lo[3][0], lo[3][1]});
            f32x4 cum[4];
            const f32x4 zero4 = {0.f, 0.f, 0.f, 0.f};
            cum[0] = __builtin_amdgcn_mfma_f32_16x16x32_bf16(FA, hF0, zero4, 0, 0, 0);
            cum[0] = __builtin_amdgcn_mfma_f32_16x16x32_bf16(FA, lF0, cum[0], 0, 0, 0);
            cum[0] = __builtin_amdgcn_mfma_f32_16x16x32_bf16(F1, hF1, cum[0], 0, 0, 0);
            cum[0] = __builtin_amdgcn_mfma_f32_16x16x32_bf16(F1, lF1, cum[0], 0, 0, 0);
            cum[1] = __builtin_amdgcn_mfma_f32_16x16x32_bf16(FB, hF0, zero4, 0, 0, 0);
            cum[1] = __builtin_amdgcn_mfma_f32_16x16x32_bf16(FB, lF0, cum[1], 0, 0, 0);
            cum[1] = __builtin_amdgcn_mfma_f32_16x16x32_bf16(F1, hF1, cum[1], 0, 0, 0);
            cum[1] = __builtin_amdgcn_mfma_f32_16x16x32_bf16(F1, lF1, cum[1], 0, 0, 0);
            cum[2] = __builtin_amdgcn_mfma_f32_16x16x32_bf16(FA, hF1, zero4, 0, 0, 0);
            cum[2] = __builtin_amdgcn_mfma_f32_16x16x32_bf16(FA, lF1, cum[2], 0, 0, 0);
            cum[3] = __builtin_amdgcn_mfma_f32_16x16x32_bf16(FB, hF1, zero4, 0, 0, 0);
            cum[3] = __builtin_amdgcn_mfma_f32_16x16x32_bf16(FB, lF1, cum[3], 0, 0, 0);
            unsigned af[4][2];
#pragma unroll
            for (int m = 0; m < 4; ++m) {
                float av[4];
#pragma unroll
                for (int r = 0; r < 4; ++r) { const float la = (z[m][r] - sp[m][r]) - cum[m][r] - carry; av[r] = val[m][r] ? fast_exp(la) : 0.f; }
                af[m][0] = pk2(av[0], av[1]); af[m][1] = pk2(av[2], av[3]);
            }
            const bf16x8 aF0 = __builtin_bit_cast(bf16x8, (u32x4){af[0][0], af[0][1], af[1][0], af[1][1]});
            const bf16x8 aF1 = __builtin_bit_cast(bf16x8, (u32x4){af[2][0], af[2][1], af[3][0], af[3][1]});
            const float tot = __shfl(cum[0][0] + sp[0][0], ql);
            carry += tot;
#pragma unroll
            for (int d = 0; d < 4; ++d) {
                bf16x8 v0 = *(const LAS bf16x8*)(Vt + (16 * d + ql) * 72 + 8 * g);
                bf16x8 v1 = *(const LAS bf16x8*)(Vt + (16 * d + ql) * 72 + 32 + 8 * g);
                O[d] = __builtin_amdgcn_mfma_f32_16x16x32_bf16(v0, aF0, O[d], 0, 0, 0);
                O[d] = __builtin_amdgcn_mfma_f32_16x16x32_bf16(v1, aF1, O[d], 0, 0, 0);
            }
            if (__all(carry > SB_THR)) wave_done = true;
        }
        if (lane == 0 && !wave_done && it > 0) orw[nit & 1] = 1u;
        __syncthreads();
        const unsigned more = orw[nit & 1];
        if (tid == 0) orw[(nit + 1) & 1] = 0u;
        if (!more) break;
    }
    if (wave_valid && (qb >= 0 || b == 0)) {
        float ss = 0.f;
#pragma unroll
        for (int d = 0; d < 4; ++d) ss += (O[d].x * O[d].x + O[d].y * O[d].y) + (O[d].z * O[d].z + O[d].w * O[d].w);
        ss += __shfl_xor(ss, 16); ss += __shfl_xor(ss, 32);
        const float inv = 1.f / sqrtf(ss * (1.f / 64.f) + 1e-6f);
        bf16* yp = Yo + (size_t)tokrow(b, tq) * DM + 512 + h * 64;
        const float* gp = p.sb_gain + l * 512 + h * 64;
#pragma unroll
        for (int d = 0; d < 4; ++d) {
            const f32x4 gg = *(const f32x4*)(gp + 16 * d + 4 * g);
            const f32x4 v = O[d] * inv * gg;
            u32x2 w; w.x = pk2(v.x, v.y); w.y = pk2(v.z, v.w);
            *(u32x2*)(yp + 16 * d + 4 * g) = w;
        }
    }
}

__device__ __forceinline__ void mix_phase(const Params& p_in, int l, LAS unsigned char* lds, int cslot = -1) {
#if defined(__HIP_DEVICE_COMPILE__)
    const Params p = *kargs();
#else
    const Params& p = p_in;
#endif
    const int tid = ltid();
    const int G = gridDim.x;
#ifdef CHAINS_HIGH
    for (int c = (int)blockIdx.x - (G - NB * 8); c < NB * 8; c += G) if (c >= 0) rwkv_chain(
#else
    for (int c = blockIdx.x; c < NB * 8; c += G) rwkv_chain(
#endif
    p, l, c >> 3, c & 7, lds, tid);
    unsigned* ctr = (unsigned*)(p.ws + WS_CTL) + 64 * (cslot < 0 ? l + 1 : cslot);
    volatile LAS unsigned* qw = (volatile LAS unsigned*)(lds + SB_Q);
    for (;;) {
        __syncthreads();
        if (tid == 0) qw[0] = atomicAdd(ctr, 1u);
        __syncthreads();
        const unsigned u = qw[0];
        if (u >= 2048u + 8u) break;
        if (u < 2048u) { const int qb = 15 - (int)(u >> 7), bh = (int)(u & 127u); sb_unit(p, l, bh >> 3, bh & 7, qb, lds, tid); }
        else sb_unit(p, l, 0, (int)(u - 2048u), -1, lds, tid);
    }
}


#ifdef DIAG_W
__device__ __forceinline__ bool check_win(const Params& p) {
    const int t = ltid(), xl = blockIdx.x >> 3, nxl = gridDim.x >> 3;
    bool bad = false;
    for (int l = 0; l < NL; ++l) {
        const float* W = p.w_in + (size_t)l * DM * INC; const bf16* WT = (const bf16*)(p.ws + WS_WIN + l * SZ_WIN);
        for (int g = xl * NTHR + t; g < INC * (DM / 8); g += nxl * NTHR) {
            const int n = g / (DM / 8), k0 = (g % (DM / 8)) * 8;
            const u32x4 v = *(const u32x4*)(WT + (size_t)n * DM + k0);
            const unsigned vv[4] = {v.x, v.y, v.z, v.w};
#pragma unroll
            for (int j = 0; j < 4; ++j) { const unsigned e = pk2(W[(size_t)(k0 + 2 * j) * INC + n], W[(size_t)(k0 + 2 * j + 1) * INC + n]); bad |= (e != vv[j]); }
        }
    }
    return __any(bad);
}
#endif

#define XB_TMO      128
#define XB_XCNT(j)  (256  + 64 * (j))
#define XB_XSUB(j)  (1280 + 64 * (j))
#define XB_XGEN(j)  (2304 + 64 * (j))
#define XB_TOP      3328
#define XB_TOPGEN   3392
#define XCD_BAR_WORDS 3456
#define XB_SPIN_CAP (1u << 18)

__device__ __forceinline__ unsigned xb_ld(unsigned* p)              { return __hip_atomic_load(p, __ATOMIC_RELAXED, __HIP_MEMORY_SCOPE_AGENT); }
__device__ __forceinline__ unsigned xb_add(unsigned* p, unsigned v) { return __hip_atomic_fetch_add(p, v, __ATOMIC_RELAXED, __HIP_MEMORY_SCOPE_AGENT); }
__device__ __forceinline__ unsigned xb_xcc_id() { return (unsigned)__builtin_amdgcn_s_getreg((3 << 11) | 20) & 0xFu; }
#define XB_SPIN(cond, bar) do { unsigned _sp = 0; while (cond) { __builtin_amdgcn_s_sleep(1); \
    if ((++_sp & 255u) == 0u) { if (xb_ld(&(bar)[XB_TMO])) break; if (_sp > XB_SPIN_CAP) { atomicAdd(&(bar)[XB_TMO], 1u); break; } } } } while (0)

struct XcdBarrier {
    unsigned* bar; unsigned x;
    volatile LAS unsigned* st;
};

__device__ __forceinline__ XcdBarrier xcd_barrier_post(unsigned* bar, volatile LAS unsigned* st) {
    XcdBarrier b; b.bar = bar; b.x = xb_xcc_id(); b.st = st;
    if (threadIdx.x == 0) (void)xb_add(&bar[XB_XCNT(b.x)], 1u);
    return b;
}
__device__ __forceinline__ void xcd_barrier_complete(unsigned* bar, unsigned x, unsigned& nloc, unsigned& nx) {
    const unsigned G = gridDim.x * gridDim.y * gridDim.z;
    unsigned sum, cnt, mine, sp = 0u;
    for (;;) {
        sum = 0u; cnt = 0u; mine = 0u;
#pragma unroll
        for (unsigned j = 0; j < 16; ++j) { const unsigned c = xb_ld(&bar[XB_XCNT(j)]); sum += c; cnt += (c > 0u) ? 1u : 0u; mine = (j == x) ? c : mine; }
        if (sum == G) break;
        __builtin_amdgcn_s_sleep(1);
        if ((++sp & 255u) == 0u) { if (xb_ld(&bar[XB_TMO])) break; if (sp > XB_SPIN_CAP) { atomicAdd(&bar[XB_TMO], 1u); break; } }
    }
    nloc = mine > 0u ? mine : 1u; nx = cnt > 0u ? cnt : 1u;
}

__device__ __forceinline__ void xcd_barrier(const XcdBarrier& b) {
    asm volatile("s_waitcnt vmcnt(0)" ::: "memory");
    __syncthreads();
    if (threadIdx.x == 0) {
        unsigned* bar = b.bar;
        __builtin_amdgcn_s_waitcnt(0);
        unsigned nloc = b.st[0], nx = b.st[1];
        if (nloc == 0u) { xcd_barrier_complete(bar, b.x, nloc, nx); b.st[0] = nloc; b.st[1] = nx; }
        const unsigned old = xb_add(&bar[XB_XSUB(b.x)], 1u);
        const unsigned gen = old / nloc;
        if (old + 1u == (gen + 1u) * nloc) {
            __builtin_amdgcn_fence(__ATOMIC_RELEASE, "agent");
            asm volatile("s_waitcnt vmcnt(0)" ::: "memory");
            const unsigned og = xb_add(&bar[XB_TOP], 1u);
            const unsigned tg = og / nx;
            if (og + 1u == (tg + 1u) * nx) xb_add(&bar[XB_TOPGEN], 1u);
            else XB_SPIN(xb_ld(&bar[XB_TOPGEN]) == tg, bar);
            __builtin_amdgcn_fence(__ATOMIC_ACQUIRE, "agent");
            xb_add(&bar[XB_XGEN(b.x)], 1u);
            asm volatile("s_waitcnt vmcnt(0)" ::: "memory");
        } else {
            XB_SPIN(xb_ld(&bar[XB_XGEN(b.x)]) == gen, bar);
            __builtin_amdgcn_fence(__ATOMIC_ACQUIRE, "agent");
            asm volatile("s_waitcnt vmcnt(0)" ::: "memory");
        }
    }
    __syncthreads();
}

template <int N, int K, int ACT>
__device__ __forceinline__ void gemm_call(const bf16* A, const bf16* Bt, bf16* O, LAS unsigned char* lds) {
    pg8::Gemm gm{A, Bt, MR, N, K};
    pg8::StaticOrder S; S.init(MR, N, gridDim.x, blockIdx.x);
    EpiOut E{O, N, ACT};
    pg8::gemm_phase<EpiOut, pg8::StaticOrder, true, true>(lds, gm, S, E);
    { const int t = ltid(); meta_gemm(A, Bt, N, K, O, ACT, blockIdx.x * NWAVES + (t >> 6), gridDim.x * NWAVES, t & 63); }
}

template <int K>
__device__ __forceinline__ void gemm_call_f32(const bf16* A, const bf16* Bt, float* lo, float* hi, LAS unsigned char* lds) {
    pg8::Gemm gm{A, Bt, MR, DM, K};
    pg8::StaticOrder S; S.init(MR, DM, gridDim.x, blockIdx.x);
    EpiF32Split E{lo, hi};
    pg8::gemm_phase<EpiF32Split, pg8::StaticOrder, true, true>(lds, gm, S, E);
    { const int t = ltid(); meta_gemm(A, Bt, DM, K, nullptr, 0, blockIdx.x * NWAVES + (t >> 6), gridDim.x * NWAVES, t & 63, lo, hi); }
}

__global__ void __launch_bounds__(NTHR, 2) trunk_fwd(Params p_unused) {
#if defined(__HIP_DEVICE_COMPILE__)
#define KP (kargs())
    extern __shared__ __attribute__((aligned(16))) unsigned char shm[];
    LAS unsigned char* lds = (LAS unsigned char*)shm;
    cg::grid_group grid = cg::this_grid();
#ifndef POST_SLEEP
#define POST_SLEEP 0
#endif
#ifdef USE_XCD_BARRIER
    volatile LAS unsigned* bst = (volatile LAS unsigned*)(lds + 131072 + 64);
    if (threadIdx.x < 2) bst[threadIdx.x] = 0u;
    __syncthreads();
    (void)xcd_barrier_post((unsigned*)(KP->ws + WS_BAR), bst);
    grid.sync();
#define GSYNC() do { XcdBarrier xb_; xb_.bar = (unsigned*)(KP->ws + WS_BAR); xb_.x = xb_xcc_id(); xb_.st = (volatile LAS unsigned*)(lds + 131072 + 64); xcd_barrier(xb_); } while (0)
#else
#define GSYNC() do { asm volatile("s_waitcnt vmcnt(0)" ::: "memory"); __threadfence(); asm volatile("s_waitcnt vmcnt(0)" ::: "memory"); grid.sync(); __threadfence(); for (int s_ = 0; s_ < POST_SLEEP; ++s_) __builtin_amdgcn_s_sleep(127); } while (0)
#endif
#define RA ((bf16*)(KP->ws + WS_RA))
#define RB ((bf16*)(KP->ws + WS_RB))
#define HM ((float*)(KP->ws + WS_HM))
    { unsigned* ctl0 = (unsigned*)(KP->ws + WS_CTL); if (blockIdx.x == 0 && threadIdx.x < 8) ctl0[64 * threadIdx.x] = 0u; }
    { const Params pc_ = *KP; conv_phase(pc_, lds); }
    norm_phase(nullptr, nullptr, nullptr, KP->x, KP->meta, KP->out, HM, KP->g_pre_mix, RA);
    GSYNC();
#ifdef DIAG_W
    const bool wbad = check_win(p);
#endif
    for (int l = 0; l < NL; ++l) {
        for (int gi = 0; gi < 4; ++gi) {
            if (gi == 1) {
                #ifdef PROBE_MIX2
                for (int rep = 0; rep < 2; ++rep) { if (rep) GSYNC(); const Params pm_ = *KP; mix_phase(pm_, l, lds, rep ? (l == 0 ? 0 : 4 + l) : -1); }
#else
                { const Params pm_ = *KP; mix_phase(pm_, l, lds); }
#endif
                GSYNC();
            }
            if (gi == 0) gemm_call<INC, DM, 0>(RA, (const bf16*)(KP->ws + WS_WIN + l * SZ_WIN), RB, lds);
            else if (gi == 1) gemm_call_f32<DM>(RA, (const bf16*)(KP->ws + WS_WOUT + l * SZ_WOUT), (float*)RB, (float*)RB + (size_t)MT * 512, lds);
            else if (gi == 2) gemm_call<DFF, DM, 1>(RA, (const bf16*)(KP->ws + WS_WUP + l * SZ_WUP), RB, lds);
            else gemm_call_f32<DFF>(RB, (const bf16*)(KP->ws + WS_WDN + l * SZ_WDN), (float*)RA, (float*)(KP->ws + WS_T2HI), lds);
            GSYNC();
            if (gi == 1) {
                norm_phase((const float*)RB, (const float*)RB + (size_t)MT * 512, KP->g_post_mix + l * DM, l == 0 ? KP->x : KP->out, l == 0 ? KP->meta : HM, KP->out, HM, KP->g_pre_ffn + l * DM, RA);
                GSYNC();
            } else if (gi == 3) {
                norm_phase((const float*)RA, (const float*)(KP->ws + WS_T2HI), KP->g_post_ffn + l * DM, KP->out, HM, KP->out, HM, l + 1 < NL ? KP->g_pre_mix + (l + 1) * DM : nullptr, RA);
                if (l + 1 < NL) GSYNC();
            }
        }
    }
#ifdef DIAG_W
    GSYNC();
    if (wbad && threadIdx.x == 0) KP->out[blockIdx.x] += 100000.f;
#endif
#undef RA
#undef RB
#undef HM
#endif
}

extern "C" void kernel_launch(void* const* d_in, const int* in_sizes, int n_in, void* d_out, int out_size, void* d_ws, size_t ws_size, hipStream_t stream) {
    static int grid = 0;
    if (grid == 0) {
        if (n_in != 22 || ws_size < WS_END) { fprintf(stderr, "kernel_launch: unexpected n_in %d / ws_size %zu (need %zu)\n", n_in, ws_size, (size_t)WS_END); grid = -1; return; }
        int dev = 0, cus = 0, per_cu = 0;
        hipGetDevice(&dev);
        hipDeviceGetAttribute(&cus, hipDeviceAttributeMultiprocessorCount, dev);
        if (hipFuncSetAttribute((const void*)trunk_fwd, hipFuncAttributeMaxDynamicSharedMemorySize, LDS_BYTES) != hipSuccess) { fprintf(stderr, "kernel_launch: hipFuncSetAttribute failed\n"); grid = -1; return; }
        if (hipOccupancyMaxActiveBlocksPerMultiprocessor(&per_cu, (const void*)trunk_fwd, NTHR, LDS_BYTES) != hipSuccess || per_cu < 1) { fprintf(stderr, "kernel_launch: occupancy query says %d\n", per_cu); per_cu = 1; }
        (void)hipGetLastError();
        grid = cus * per_cu;
        fprintf(stderr, "kernel_launch: grid %d (cus %d x %d)\n", grid, cus, per_cu);
    }
    if (grid < 0) return;
    if (hipMemsetAsync((char*)d_ws + WS_CTL, 0, WS_HM, stream) != hipSuccess) { fprintf(stderr, "kernel_launch: memset failed\n"); return; }
    Params p{};
    const float** f = (const float**)&p;
    for (int i = 0; i < 22; ++i) f[i] = (const float*)d_in[i];
    p.out = (float*)d_out; p.ws = (unsigned char*)d_ws;
    void* args[] = {&p};
    hipError_t e = hipLaunchCooperativeKernel((const void*)trunk_fwd, dim3(grid), dim3(NTHR), args, LDS_BYTES, stream);
    if (e != hipSuccess) fprintf(stderr, "cooperative launch failed: %s (grid %d)\n", hipGetErrorString(e), grid);
}
```

```cpp
#define SCAN_UNROLL 2
#define USE_XCD_BARRIER 1
#include <hip/hip_runtime.h>
#include <hip/hip_cooperative_groups.h>
#include <cstdio>
#include <cstdint>
namespace cg = cooperative_groups;
namespace pg8 {
#define PG8_LAS __attribute__((address_space(3)))
#ifndef PG8_AUX
#define PG8_AUX 2
#endif
typedef unsigned short bf16_t;
typedef short bf16x8 __attribute__((ext_vector_type(8)));
typedef float f32x4 __attribute__((ext_vector_type(4)));
typedef unsigned u32x4 __attribute__((ext_vector_type(4)));
constexpr int BM = 256, BK = 64, HALF = 128, HTB = HALF * BK * 2  , STAGE_BYTES = 8 * HTB, NXCD = 8, WGM = 8;

__host__ __device__ __forceinline__ int lds_byte(int r, int c) { const int st = (r >> 4) * 2 + (c >> 5), rr = r & 15, cc = c & 31, ob = rr * 64 + cc * 2; return st * 1024 + (ob ^ (((ob >> 9) & 1) << 5)); }
__host__ __device__ __forceinline__ void stage_rc(int b, int& R, int& C) { const int st = b / 1024, sb = b % 1024, swz = sb ^ (((sb >> 9) & 1) << 5); R = (st >> 1) * 16 + swz / 64; C = (st & 1) * 32 + (swz % 64) / 2; }
__host__ __device__ __forceinline__ int perm32(int rho) { const int n = rho >> 4, i = rho & 15; return 8 * (i >> 2) + 4 * n + (i & 3); }

struct Unit { int pm, pn; };
struct Gemm { const bf16_t* A; const bf16_t* Bt; int M, N, K; };

struct StaticOrder {
    int nM, nN, nwg, G, c;
    __host__ __device__ void init(int M, int N, int G_, int c_) { nM = M / BM; nN = N / BM; nwg = nM * nN; G = G_; c = c_; }
    __host__ __device__ bool next(int i, Unit& u) const {
        const long L = (long)i * G + c; if (L >= nwg) return false;
        int wgid = (int)L; { const int q = nwg / NXCD, r = nwg % NXCD, xcd = wgid % NXCD, off = wgid / NXCD; wgid = (xcd < r ? xcd * (q + 1) : r * (q + 1) + (xcd - r) * q) + off; }
        const int nig = WGM * nN, gid = wgid / nig, fm = gid * WGM, gsz = (nM - fm) < WGM ? (nM - fm) : WGM;
        u.pm = fm + ((wgid % nig) % gsz); u.pn = (wgid % nig) / gsz; return true;
    }
    __device__ __forceinline__ void a_ready(const Unit&) const {}
    __device__ __forceinline__ void done(const Unit&) const {}
};

__device__ __forceinline__ unsigned cvt_pk_bf16(float lo, float hi) { unsigned r; asm volatile("v_cvt_pk_bf16_f32 %0, %1, %2" : "=v"(r) : "v"(lo), "v"(hi)); return r; }
typedef float f32x2 __attribute__((ext_vector_type(2)));
template <class Epi, class Sched, bool ALIGN_EPI = false, bool SP2 = false>
__device__ __forceinline__ void gemm_phase(PG8_LAS unsigned char* lds, const Gemm g, const Sched& S, const Epi& E) {
    int tid_ = threadIdx.x; asm volatile("" : "+v"(tid_));
    const int tid = tid_, wid = __builtin_amdgcn_readfirstlane(tid >> 6), lane = tid & 63, wr = wid >> 2, wc = wid & 3, fr = lane & 15, fq = lane >> 4;
    const int K = g.K, nt = K / BK;
    unsigned voffA[2], voffB[2];
#pragma unroll
    for (int i = 0; i < 2; ++i) { int R, C; stage_rc(tid * 16 + i * 8192, R, C); const int Rb = Epi::PERM ? ((R & ~31) + perm32(R & 31)) : R;
        voffA[i] = (unsigned)(R * K + C) * 2u; voffB[i] = (unsigned)(Rb * K + C) * 2u; }
    const size_t kstep = (size_t)(BK * 2);
    const size_t hstep = (size_t)HALF * K * 2;
    const size_t tstep = 2 * hstep;
    const unsigned ldsw = (unsigned)wid * 1024u;
    const int aoff = lds_byte(wr * 64 + fr, fq * 8), boff = lds_byte(wc * 32 + fr, fq * 8);
#define PG8_SA(b, h) (((b) * 2 + (h)) * HTB)
#define PG8_SB(b, h) ((4 + (b) * 2 + (h)) * HTB)
#define PG8_STAGE(bufoff, gbase, voff) do { _Pragma("unroll") for (int _i = 0; _i < 2; ++_i) \
        __builtin_amdgcn_global_load_lds((const unsigned*)((const char*)(gbase) + (voff)[_i]), (PG8_LAS unsigned*)(lds + (bufoff) + ldsw + _i * 8192), 16, 0, 0); } while (0)
#define PG8_LDA(dst, b, h) do { _Pragma("unroll") for (int m = 0; m < 4; ++m) _Pragma("unroll") for (int k = 0; k < 2; ++k) dst[m][k] = *(const PG8_LAS bf16x8*)(lds + PG8_SA(b, h) + aoff + m * 2048 + k * 1024); } while (0)
#define PG8_LDB(dst, b, h) do { _Pragma("unroll") for (int n = 0; n < 2; ++n) _Pragma("unroll") for (int k = 0; k < 2; ++k) dst[n][k] = *(const PG8_LAS bf16x8*)(lds + PG8_SB(b, h) + boff + n * 2048 + k * 1024); } while (0)
#define PG8_MMA(ai, bj, At, Bt) do { __builtin_amdgcn_s_setprio(1); _Pragma("unroll") for (int m = 0; m < 4; ++m) _Pragma("unroll") for (int n = 0; n < 2; ++n) _Pragma("unroll") for (int k = 0; k < 2; ++k) \
        acc[ai][bj][m][n] = __builtin_amdgcn_mfma_f32_16x16x32_bf16(Bt[n][k], At[m][k], acc[ai][bj][m][n], 0, 0, 0); __builtin_amdgcn_s_setprio(0); } while (0)
#define PG8_WAIT_V(n) asm volatile("s_waitcnt vmcnt(" #n ")" ::: "memory")
#define PG8_WAIT_L(n) asm volatile("s_waitcnt lgkmcnt(" #n ")" ::: "memory")
#define PG8_BAR __builtin_amdgcn_s_barrier()
#define PG8_SCHED __builtin_amdgcn_sched_barrier(0)
    Unit cur, nxt; int ui = 0;
    if (!S.next(0, cur)) return;
    f32x4 acc[2][2][4][2];
#pragma unroll
    for (int a = 0; a < 2; ++a)
#pragma unroll
        for (int b = 0; b < 2; ++b)
#pragma unroll
            for (int m = 0; m < 4; ++m)
#pragma unroll
                for (int n = 0; n < 2; ++n) acc[a][b][m][n] = (f32x4){0.f, 0.f, 0.f, 0.f};
    bf16x8 At[4][2], B0[2][2], B1[2][2];
    const char* cA = (const char*)g.A + (size_t)cur.pm * tstep; const char* cB = (const char*)g.Bt + (size_t)cur.pn * tstep;
    S.a_ready(cur);
    if constexpr (SP2) {
        PG8_STAGE(PG8_SB(0, 0), cB, voffB); PG8_STAGE(PG8_SB(0, 1), cB + hstep, voffB); PG8_STAGE(PG8_SA(0, 0), cA, voffA); PG8_STAGE(PG8_SA(0, 1), cA + hstep, voffA);
        if (wr == 1) PG8_BAR;
        PG8_WAIT_V(2); PG8_BAR;
        PG8_STAGE(PG8_SB(1, 0), cB + kstep, voffB); PG8_STAGE(PG8_SA(1, 0), cA + kstep, voffA); PG8_STAGE(PG8_SB(1, 1), cB + hstep + kstep, voffB);
        PG8_WAIT_V(6); PG8_BAR;
    } else {
        PG8_STAGE(PG8_SB(0, 0), cB, voffB); PG8_STAGE(PG8_SA(0, 0), cA, voffA); PG8_STAGE(PG8_SB(0, 1), cB + hstep, voffB); PG8_STAGE(PG8_SA(0, 1), cA + hstep, voffA);
        if (wr == 1) PG8_BAR;
        PG8_WAIT_V(4); PG8_BAR;
        PG8_STAGE(PG8_SB(1, 0), cB + kstep, voffB); PG8_STAGE(PG8_SA(1, 0), cA + kstep, voffA); PG8_STAGE(PG8_SB(1, 1), cB + hstep + kstep, voffB);
        PG8_WAIT_V(6); PG8_BAR;
    }
    for (;;) {
        const bool has_next = S.next(ui + 1, nxt);
        const char* nA = has_next ? (const char*)g.A + (size_t)nxt.pm * tstep : cA; const char* nB = has_next ? (const char*)g.Bt + (size_t)nxt.pn * tstep : cB;
        for (int t = 0; t < nt; t += 2) {
            const bool last = (t == nt - 2);
            const char* a1 = cA + (size_t)(t + 1) * kstep;
            const char* a2 = last ? nA : cA + (size_t)(t + 2) * kstep; const char* b2 = last ? nB : cB + (size_t)(t + 2) * kstep;
            const char* a3 = a2 + kstep; const char* b3 = b2 + kstep;
            if (last && has_next) S.a_ready(nxt);
            if constexpr (SP2) {
            PG8_LDB(B0, 0, 0); PG8_LDB(B1, 0, 1); PG8_SCHED; PG8_LDA(At, 0, 0); PG8_STAGE(PG8_SA(1, 1), a1 + hstep, voffA);
            PG8_WAIT_V(8); PG8_WAIT_L(0); PG8_BAR; PG8_MMA(0, 0, At, B0); PG8_MMA(0, 1, At, B1); PG8_BAR; PG8_SCHED;
            PG8_LDA(At, 0, 1); PG8_STAGE(PG8_SB(0, 0), b2, voffB); PG8_STAGE(PG8_SB(0, 1), b2 + hstep, voffB); PG8_STAGE(PG8_SA(0, 0), a2, voffA);
            PG8_WAIT_V(8); PG8_WAIT_L(0); PG8_BAR; PG8_MMA(1, 0, At, B0); PG8_MMA(1, 1, At, B1); PG8_BAR; PG8_SCHED;
            PG8_LDB(B0, 1, 0); PG8_LDB(B1, 1, 1); PG8_SCHED; PG8_LDA(At, 1, 0); PG8_STAGE(PG8_SA(0, 1), a2 + hstep, voffA);
            PG8_WAIT_V(8); PG8_WAIT_L(0); PG8_BAR; PG8_MMA(0, 0, At, B0); PG8_MMA(0, 1, At, B1); PG8_BAR; PG8_SCHED;
            PG8_LDA(At, 1, 1); PG8_STAGE(PG8_SB(1, 0), b3, voffB); PG8_STAGE(PG8_SB(1, 1), b3 + hstep, voffB); PG8_STAGE(PG8_SA(1, 0), a3, voffA);
            PG8_WAIT_V(8); PG8_WAIT_L(0); PG8_BAR; PG8_MMA(1, 0, At, B0); PG8_MMA(1, 1, At, B1); PG8_BAR; PG8_SCHED;
            } else {
            PG8_LDB(B0, 0, 0); PG8_SCHED; PG8_LDA(At, 0, 0); PG8_STAGE(PG8_SA(1, 1), a1 + hstep, voffA);
            PG8_WAIT_L(8); PG8_BAR; PG8_WAIT_L(0); PG8_MMA(0, 0, At, B0); PG8_BAR; PG8_SCHED;
            PG8_LDB(B1, 0, 1); PG8_STAGE(PG8_SB(0, 0), b2, voffB);
            PG8_BAR; PG8_WAIT_L(0); PG8_MMA(0, 1, At, B1); PG8_BAR;
            PG8_LDA(At, 0, 1); PG8_STAGE(PG8_SA(0, 0), a2, voffA);
            PG8_BAR; PG8_WAIT_L(0); PG8_MMA(1, 0, At, B0); PG8_BAR; PG8_SCHED;
            PG8_STAGE(PG8_SB(0, 1), b2 + hstep, voffB);
            PG8_WAIT_V(6); PG8_BAR; PG8_MMA(1, 1, At, B1); PG8_BAR;
            PG8_LDB(B0, 1, 0); PG8_SCHED; PG8_LDA(At, 1, 0); PG8_STAGE(PG8_SA(0, 1), a2 + hstep, voffA);
            PG8_WAIT_L(8); PG8_BAR; PG8_WAIT_L(0); PG8_MMA(0, 0, At, B0); PG8_BAR; PG8_SCHED;
            PG8_LDB(B1, 1, 1); PG8_STAGE(PG8_SB(1, 0), b3, voffB);
            PG8_BAR; PG8_WAIT_L(0); PG8_MMA(0, 1, At, B1); PG8_BAR;
            PG8_LDA(At, 1, 1); PG8_STAGE(PG8_SA(1, 0), a3, voffA);
            PG8_BAR; PG8_WAIT_L(0); PG8_MMA(1, 0, At, B0); PG8_BAR; PG8_SCHED;
            PG8_STAGE(PG8_SB(1, 1), b3 + hstep, voffB);
            PG8_WAIT_V(6); PG8_BAR; PG8_MMA(1, 1, At, B1); PG8_BAR;
            }
        }
        if constexpr (ALIGN_EPI) { if (wr == 0) PG8_BAR; }
        if constexpr (!Epi::AFTER_DRAIN) { E(acc, cur, wr, wc, fr, fq); S.done(cur); }
        if (!has_next) break;
#pragma unroll
        for (int a = 0; a < 2; ++a)
#pragma unroll
            for (int b = 0; b < 2; ++b)
#pragma unroll
                for (int m = 0; m < 4; ++m)
#pragma unroll
                    for (int n = 0; n < 2; ++n) acc[a][b][m][n] = (f32x4){0.f, 0.f, 0.f, 0.f};
        cur = nxt; cA = nA; cB = nB; ++ui;
        if constexpr (ALIGN_EPI) { if (wr == 1) PG8_BAR; }
    }
    PG8_WAIT_V(0);
    if constexpr (!ALIGN_EPI) { if (wr == 0) PG8_BAR; }
    PG8_BAR;
    if constexpr (Epi::AFTER_DRAIN) { E.fused(acc, cur, wr, wc, fr, fq, lds, wid, lane); S.done(cur); }
#undef PG8_SA
#undef PG8_SB
#undef PG8_STAGE
#undef PG8_LDA
#undef PG8_LDB
#undef PG8_MMA
#undef PG8_WAIT_V
#undef PG8_WAIT_L
#undef PG8_BAR
#undef PG8_SCHED
}
}


#define LAS __attribute__((address_space(3)))
typedef unsigned short bf16;
typedef short bf16x8 __attribute__((ext_vector_type(8)));
typedef float f32x4 __attribute__((ext_vector_type(4)));
typedef float f32x2 __attribute__((ext_vector_type(2)));
typedef unsigned u32x4 __attribute__((ext_vector_type(4)));
typedef unsigned u32x2 __attribute__((ext_vector_type(2)));

constexpr int NB = 16, SEQ = 2048, NMETA = 16, TT = SEQ + NMETA, DM = 1024, DFF = 4096, NL = 4;
constexpr int MR = NB * SEQ;
constexpr int MT = MR + NMETA;
constexpr int INC = 3328;
constexpr int C_R = 0, C_K = 512, C_V = 1024, C_DW = 1536, C_DA = 1600, C_DG = 1664, C_Q = 1792, C_SK = 2304, C_SV = 2816;
constexpr int NWAVES = 8, NTHR = 512;
constexpr int LDS_BYTES = 147456;

constexpr size_t WS_CTL = 0;
constexpr size_t WS_BAR = 4096;
constexpr size_t WS_HM = 20480;
constexpr size_t WS_WIN = WS_HM + (size_t)NMETA * DM * 4;
constexpr size_t SZ_WIN = (size_t)INC * DM * 2;
constexpr size_t WS_WOUT = WS_WIN + NL * SZ_WIN;
constexpr size_t SZ_WOUT = (size_t)DM * DM * 2;
constexpr size_t WS_WUP = WS_WOUT + NL * SZ_WOUT;
constexpr size_t SZ_WUP = (size_t)DFF * DM * 2;
constexpr size_t WS_WDN = WS_WUP + NL * SZ_WUP;
constexpr size_t SZ_WDN = SZ_WUP;
constexpr size_t WS_WD = WS_WDN + NL * SZ_WDN;
constexpr size_t SZ_WD = (size_t)512 * 64 * 2;
constexpr size_t WS_WA = WS_WD + NL * SZ_WD;
constexpr size_t WS_WG = WS_WA + NL * SZ_WD;
constexpr size_t SZ_WG = (size_t)512 * 128 * 2;
constexpr size_t WS_RA = WS_WG + NL * SZ_WG;
constexpr size_t SZ_RA = (size_t)MT * DM * 2;
constexpr size_t WS_RB = WS_RA + SZ_RA;
constexpr size_t SZ_RB = (size_t)MT * DFF * 2;
constexpr size_t WS_T2HI = WS_RB + SZ_RB;
constexpr size_t WS_END = WS_T2HI + (size_t)MT * 512 * 4;

struct Params {
    const float* x; const float* meta; const float* g_pre_mix; const float* g_post_mix; const float* g_pre_ffn; const float* g_post_ffn;
    const float* w_in; const float* mu; const float* w_decay_up; const float* decay_bias; const float* w_a_up; const float* a_bias; const float* w_g_up;
    const float* k_k; const float* k_a; const float* r_k; const float* lnx_gain; const float* lnx_bias; const float* sb_gain;
    const float* w_out; const float* w_up; const float* w_dn;
    float* out; unsigned char* ws;
};

typedef const __attribute__((address_space(4))) Params* KParams;
__device__ __forceinline__ KParams kargs() { KParams k = (KParams)__builtin_amdgcn_kernarg_segment_ptr(); asm volatile("" : "+s"(k)); return k; }
__device__ __forceinline__ int ltid() { int t = threadIdx.x; asm volatile("" : "+v"(t)); return t; }
__device__ __forceinline__ unsigned f2bf(float f) { unsigned u = __builtin_bit_cast(unsigned, f); return (u + 0x7fffu + ((u >> 16) & 1u)) >> 16; }
__device__ __forceinline__ unsigned pk2(float lo, float hi) { unsigned r; asm volatile("v_cvt_pk_bf16_f32 %0, %1, %2" : "=v"(r) : "v"(lo), "v"(hi)); return r; }
__device__ __forceinline__ float bflo(unsigned u) { return __builtin_bit_cast(float, u << 16); }
__device__ __forceinline__ float bfhi(unsigned u) { return __builtin_bit_cast(float, u & 0xffff0000u); }
__device__ __forceinline__ int tokrow(int b, int t) { return t < NMETA ? MR + t : b * SEQ + (t - NMETA); }
__device__ __forceinline__ float wave_sum(float v) {
#pragma unroll
    for (int o = 1; o < 64; o <<= 1) v += __shfl_xor(v, o);
    return v;
}

template <int CTRL> __device__ __forceinline__ float dppf(float x) {
    return __builtin_bit_cast(float, __builtin_amdgcn_update_dpp(0, __builtin_bit_cast(int, x), CTRL, 0xF, 0xF, true));
}
__device__ __forceinline__ float sum8(float v) {
    v += dppf<0xB1>(v);
    v += dppf<0x4E>(v);
    v += dppf<0x141>(v);
    return v;
}
__device__ __forceinline__ float sum16(float v) {
    v += dppf<0xB1>(v);
    v += dppf<0x4E>(v);
    v += dppf<0x141>(v);
    v += dppf<0x140>(v);
    return v;
}
__device__ __forceinline__ float fast_exp(float x) { return __builtin_amdgcn_exp2f(x * 1.4426950408889634f); }
__device__ __forceinline__ float fast_log(float x) { return __builtin_amdgcn_logf(x) * 0.6931471805599453f; }
__device__ __forceinline__ float softplusf(float z) { return fmaxf(z, 0.f) + fast_log(1.f + fast_exp(-fabsf(z))); }
__device__ __forceinline__ float sigmoidf_(float z) { return __builtin_amdgcn_rcpf(1.f + fast_exp(-z)); }

template <class T> __device__ __forceinline__ T ldnt(const void* p) { return __builtin_nontemporal_load((const T*)p); }

struct EpiOut {
    static constexpr bool PERM = true, AFTER_DRAIN = false;
    bf16* O; int ldc; int act;
    __device__ __forceinline__ void operator()(const f32x4 (&acc)[2][2][4][2], const pg8::Unit& u, int wr, int wc, int fr, int fq) const {
        const int row0 = u.pm * 256 + wr * 64 + fr, col0 = u.pn * 256 + wc * 32 + 8 * fq;
#pragma unroll
        for (int ai = 0; ai < 2; ++ai)
#pragma unroll
            for (int m = 0; m < 4; ++m) { bf16* rowp = O + (size_t)(row0 + ai * 128 + m * 16) * ldc + col0;
#pragma unroll
                for (int bj = 0; bj < 2; ++bj) { f32x4 v0 = acc[ai][bj][m][0], v1 = acc[ai][bj][m][1];
                    if (act) {
#pragma unroll
                        for (int e = 0; e < 4; ++e) { float a = fmaxf(v0[e], 0.f), b = fmaxf(v1[e], 0.f); v0[e] = a * a; v1[e] = b * b; } }
                    u32x4 w; w.x = pk2(v0[0], v0[1]); w.y = pk2(v0[2], v0[3]); w.z = pk2(v1[0], v1[1]); w.w = pk2(v1[2], v1[3]);
                    *(u32x4*)(rowp + bj * 128) = w; } }
    }
};

struct EpiF32Split {
    static constexpr bool PERM = true, AFTER_DRAIN = false;
    float* lo; float* hi;
    __device__ __forceinline__ void operator()(const f32x4 (&acc)[2][2][4][2], const pg8::Unit& u, int wr, int wc, int fr, int fq) const {
        const int row0 = u.pm * 256 + wr * 64 + fr, col0 = (u.pn & 1) * 256 + wc * 32 + 8 * fq;
        float* base = (u.pn < 2) ? lo : hi;
#pragma unroll
        for (int ai = 0; ai < 2; ++ai)
#pragma unroll
            for (int m = 0; m < 4; ++m) { float* rowp = base + (size_t)(row0 + ai * 128 + m * 16) * 512 + col0;
#pragma unroll
                for (int bj = 0; bj < 2; ++bj) { *(f32x4*)(rowp + bj * 128) = acc[ai][bj][m][0]; *(f32x4*)(rowp + bj * 128 + 4) = acc[ai][bj][m][1]; } }
    }
};

__device__ __forceinline__ void meta_gemm(const bf16* A, const bf16* Bt, int N, int K, bf16* O, int act, int gw, int ngw, int lane, float* flo = nullptr, float* fhi = nullptr) {
    const int i = lane & 15, g = lane >> 4;
    for (int task = gw; task < N / 16; task += ngw) {
        const int n0 = task * 16;
        const bf16* ap = Bt + (size_t)(n0 + i) * K + 8 * g;
        const bf16* bp = A + (size_t)(MR + i) * K + 8 * g;
        f32x4 acc = {0.f, 0.f, 0.f, 0.f};
#pragma unroll 4
        for (int k0 = 0; k0 < K; k0 += 32) {
            bf16x8 a = ldnt<bf16x8>(ap + k0), b = ldnt<bf16x8>(bp + k0);
            acc = __builtin_amdgcn_mfma_f32_16x16x32_bf16(a, b, acc, 0, 0, 0);
        }
        if (act) {
#pragma unroll
            for (int e = 0; e < 4; ++e) { float a = fmaxf(acc[e], 0.f); acc[e] = a * a; } }
        if (flo) { float* base = (n0 < 512) ? flo : fhi; *(f32x4*)(base + (size_t)(MR + i) * 512 + (n0 & 511) + 4 * g) = acc; }
        else { u32x2 w; w.x = pk2(acc[0], acc[1]); w.y = pk2(acc[2], acc[3]);
        *(u32x2*)(O + (size_t)(MR + i) * N + n0 + 4 * g) = w; }
    }
}

__device__ __forceinline__ void transpose_item(const float* W, int K, int N, bf16* WT, LAS float* scr, int item, int lane) {
    const int nblk = N / 32, kb = item / nblk, nb = item % nblk, k0 = 64 * kb, n0 = 32 * nb;
#pragma unroll 8
    for (int i = 0; i < 32; ++i) { const int kk = 2 * i + (lane >> 5); scr[kk * 33 + (lane & 31)] = W[(size_t)(k0 + kk) * N + n0 + (lane & 31)]; }
    asm volatile("s_waitcnt lgkmcnt(0)" ::: "memory");
    const int c = lane & 7;
#pragma unroll
    for (int j = 0; j < 4; ++j) { const int n = (lane >> 3) + 8 * j; const LAS float* s = scr + (8 * c) * 33 + n;
        u32x4 o; o.x = pk2(s[0 * 33], s[1 * 33]); o.y = pk2(s[2 * 33], s[3 * 33]); o.z = pk2(s[4 * 33], s[5 * 33]); o.w = pk2(s[6 * 33], s[7 * 33]);
        *(u32x4*)(WT + (size_t)(n0 + n) * K + k0 + 8 * c) = o; }
    asm volatile("s_waitcnt lgkmcnt(0)" ::: "memory");
}
__device__ __forceinline__ void conv_phase(const Params& p, LAS unsigned char* lds) {
    const int t_ = ltid(), lane = t_ & 63, wave = t_ >> 6, gw = blockIdx.x * NWAVES + wave, ngw = gridDim.x * NWAVES;
    LAS float* scr = (LAS float*)(lds + wave * 16384);
    constexpr int I_IN = 16 * 104, I_OUT = 16 * 32, I_UP = 16 * 128, I_DN = 64 * 32, I_D = 16, I_A = 16, I_G = 32;
    constexpr int PER = I_IN + I_OUT + I_UP + I_DN + I_D + I_A + I_G;
    for (int it = gw; it < NL * PER; it += ngw) {
        const int l = it / PER; int r = it % PER;
        if (r < I_IN) { transpose_item(p.w_in + (size_t)l * DM * INC, DM, INC, (bf16*)(p.ws + WS_WIN + l * SZ_WIN), scr, r, lane); continue; } r -= I_IN;
        if (r < I_OUT) { transpose_item(p.w_out + (size_t)l * DM * DM, DM, DM, (bf16*)(p.ws + WS_WOUT + l * SZ_WOUT), scr, r, lane); continue; } r -= I_OUT;
        if (r < I_UP) { transpose_item(p.w_up + (size_t)l * DM * DFF, DM, DFF, (bf16*)(p.ws + WS_WUP + l * SZ_WUP), scr, r, lane); continue; } r -= I_UP;
        if (r < I_DN) { transpose_item(p.w_dn + (size_t)l * DFF * DM, DFF, DM, (bf16*)(p.ws + WS_WDN + l * SZ_WDN), scr, r, lane); continue; } r -= I_DN;
        if (r < I_D) { transpose_item(p.w_decay_up + (size_t)l * 64 * 512, 64, 512, (bf16*)(p.ws + WS_WD + l * SZ_WD), scr, r, lane); continue; } r -= I_D;
        if (r < I_A) { transpose_item(p.w_a_up + (size_t)l * 64 * 512, 64, 512, (bf16*)(p.ws + WS_WA + l * SZ_WD), scr, r, lane); continue; } r -= I_A;
        transpose_item(p.w_g_up + (size_t)l * 128 * 512, 128, 512, (bf16*)(p.ws + WS_WG + l * SZ_WG), scr, r, lane);
    }
}

__device__ __forceinline__ void norm_phase(const float* T, const float* Thi, const float* g1, const float* hin_real, const float* hin_meta, float* hout_real, float* hout_meta,
                                           const float* g2, bf16* xn) {
    const int t_ = ltid(), lane = t_ & 63, gw = blockIdx.x * NWAVES + (t_ >> 6), ngw = gridDim.x * NWAVES;
    for (int m = gw; m < MT; m += ngw) {
        const float* hi = m < MR ? hin_real + (size_t)m * DM : hin_meta + (size_t)(m - MR) * DM;
        float* ho = m < MR ? hout_real + (size_t)m * DM : hout_meta + (size_t)(m - MR) * DM;
        f32x4 h[4];
#pragma unroll
        for (int j = 0; j < 4; ++j) h[j] = *((const f32x4*)hi + lane + 64 * j);
        if (T) {
            f32x4 t[4]; float ss = 0.f;
#pragma unroll
            for (int j = 0; j < 4; ++j) { t[j] = *((const f32x4*)((j < 2 ? T : Thi) + (size_t)m * 512) + lane + 64 * (j & 1));
                ss += (t[j].x * t[j].x + t[j].y * t[j].y) + (t[j].z * t[j].z + t[j].w * t[j].w); }
            const float r1 = 1.f / sqrtf(wave_sum(ss) * (1.f / DM) + 1e-6f);
#pragma unroll
            for (int j = 0; j < 4; ++j) { f32x4 gg = *((const f32x4*)g1 + lane + 64 * j); h[j] = h[j] + t[j] * r1 * gg; *((f32x4*)ho + lane + 64 * j) = h[j]; }
        }
        if (g2) {
            float ss = 0.f;
#pragma unroll
            for (int j = 0; j < 4; ++j) ss += (h[j].x * h[j].x + h[j].y * h[j].y) + (h[j].z * h[j].z + h[j].w * h[j].w);
            const float r2 = 1.f / sqrtf(wave_sum(ss) * (1.f / DM) + 1e-6f);
            u32x2* o = (u32x2*)(xn + (size_t)m * DM) + lane;
#pragma unroll
            for (int j = 0; j < 4; ++j) { f32x4 gg = *((const f32x4*)g2 + lane + 64 * j); f32x4 v = h[j] * r2 * gg;
                u32x2 w; w.x = pk2(v.x, v.y); w.y = pk2(v.z, v.w); o[64 * j] = w; }
        }
    }
}

constexpr int RW_CH = 32;
constexpr int RW_R = 0, RW_W = 8192, RW_K = 16384, RW_V = 24576, RW_KKN = 32768, RW_B = 40960, RW_Y = 49152, RW_G = 57344;
constexpr int RW_TD = 65536, RW_DA = 70144, RW_SG = 74752, RW_BON = 83456;

__device__ __forceinline__ void rwkv_chain(const Params& p, int l, int b, int h, LAS unsigned char* lds, int tid) {
    const int wave = tid >> 6, lane = tid & 63;
    const bf16* P = (const bf16*)(p.ws + WS_RB);
    bf16* Yo = (bf16*)(p.ws + WS_RA);
    LAS float* R = (LAS float*)(lds + RW_R); LAS float* W = (LAS float*)(lds + RW_W); LAS float* Kx = (LAS float*)(lds + RW_K); LAS float* V = (LAS float*)(lds + RW_V);
    LAS float* KKN = (LAS float*)(lds + RW_KKN); LAS float* BV = (LAS float*)(lds + RW_B); LAS float* Y = (LAS float*)(lds + RW_Y); LAS float* G = (LAS float*)(lds + RW_G);
    LAS bf16* TD = (LAS bf16*)(lds + RW_TD); LAS bf16* DA = (LAS bf16*)(lds + RW_DA); LAS bf16* SG = (LAS bf16*)(lds + RW_SG); LAS float* BON = (LAS float*)(lds + RW_BON);
    const float* mu = p.mu + (size_t)l * 1792;
    const int mt = wave & 1, nt = wave >> 1, fi = lane & 15, fg = lane >> 4;
    bf16x8 wdF[2], waF[2], wgF[4];
    {
        const bf16* wd = (const bf16*)(p.ws + WS_WD + l * SZ_WD) + (size_t)(h * 64 + nt * 16 + fi) * 64 + 8 * fg;
        const bf16* wa = (const bf16*)(p.ws + WS_WA + l * SZ_WD) + (size_t)(h * 64 + nt * 16 + fi) * 64 + 8 * fg;
        const bf16* wg = (const bf16*)(p.ws + WS_WG + l * SZ_WG) + (size_t)(h * 64 + nt * 16 + fi) * 128 + 8 * fg;
        wdF[0] = *(const bf16x8*)wd; wdF[1] = *(const bf16x8*)(wd + 32);
        waF[0] = *(const bf16x8*)wa; waF[1] = *(const bf16x8*)(wa + 32);
#pragma unroll
        for (int k = 0; k < 4; ++k) wgF[k] = *(const bf16x8*)(wg + 32 * k);
    }
    const int cB = h * 64 + nt * 16 + fi;
    const float dbias = p.decay_bias[l * 512 + cB], abias = p.a_bias[l * 512 + cB];
    const int tokC = tid >> 4, ch4 = (tid & 15) * 4, cC = h * 64 + ch4;
    const f32x4 kkv = *(const f32x4*)(p.k_k + l * 512 + cC), kav = *(const f32x4*)(p.k_a + l * 512 + cC), rkv = *(const f32x4*)(p.r_k + l * 512 + cC);
    const f32x4 lgv = *(const f32x4*)(p.lnx_gain + l * 512 + cC), lbv = *(const f32x4*)(p.lnx_bias + l * 512 + cC);
    const int vrow = (tid >> 3) & 31, kq = tid & 7;
    f32x2 S[2][4];
#pragma unroll
    for (int q = 0; q < 2; ++q)
#pragma unroll
        for (int j = 0; j < 4; ++j) S[q][j] = (f32x2){0.f, 0.f};

    u32x4 pc[4], pp[4];
    LAS float* MU = (LAS float*)(lds + 83968);
    if (tid < 448) { const int gi = tid >> 3; const int col = gi < 24 ? (gi >> 3) * 512 + h * 64 + (gi & 7) * 8 : C_DW + (gi - 24) * 8; MU[tid] = mu[col + (tid & 7)]; }
#pragma unroll
    for (int k = 0; k < 4; ++k) { pc[k] = (u32x4){0u, 0u, 0u, 0u}; pp[k] = pc[k]; }
#define RW_IK(k) (((tid + NTHR * (k)) * 4682) >> 18)
#define RW_GIK(k) ((tid + NTHR * (k)) - 56 * RW_IK(k))
#define RW_COL(gi) ((gi) < 24 ? ((gi) >> 3) * 512 + h * 64 + ((gi) & 7) * 8 : C_DW + ((gi) - 24) * 8)
#define RW_ISSUE(T0, NT) do { _Pragma("unroll") for (int k = 0; k < 4; ++k) { if (tid + NTHR * k < (NT) * 56) { const int t_ = (T0) + RW_IK(k); const int c_ = RW_COL(RW_GIK(k)); \
        pc[k] = ldnt<u32x4>(P + (size_t)tokrow(b, t_) * INC + c_); pp[k] = (u32x4){0u, 0u, 0u, 0u}; \
        if (t_ > 0) pp[k] = ldnt<u32x4>(P + (size_t)tokrow(b, t_ - 1) * INC + c_); } } } while (0)
    RW_ISSUE(0, NMETA);
    __syncthreads();
    for (int t0 = 0; t0 < TT; ) {
        const int ntok = (t0 == 0) ? NMETA : RW_CH;
#pragma unroll
        for (int k = 0; k < 4; ++k) {
            if (tid + NTHR * k < ntok * 56) {
                const int i = RW_IK(k), gi = RW_GIK(k);
                float xv[8];
                {
                    const unsigned cu[4] = {pc[k].x, pc[k].y, pc[k].z, pc[k].w}, pu[4] = {pp[k].x, pp[k].y, pp[k].z, pp[k].w};
                    const f32x4 ma = *(const LAS f32x4*)(MU + gi * 8), mb = *(const LAS f32x4*)(MU + gi * 8 + 4);
                    const float mm[8] = {ma.x, ma.y, ma.z, ma.w, mb.x, mb.y, mb.z, mb.w};
#pragma unroll
                    for (int e = 0; e < 4; ++e) { float c0 = bflo(cu[e]), c1 = bfhi(cu[e]), q0 = bflo(pu[e]), q1 = bfhi(pu[e]);
                        xv[2 * e] = c0 + (q0 - c0) * mm[2 * e]; xv[2 * e + 1] = c1 + (q1 - c1) * mm[2 * e + 1]; }
                }
                if (gi < 24) {
                    LAS float* dst = (gi < 8 ? R : (gi < 16 ? Kx : V)) + i * 64 + (gi & 7) * 8;
                    *(LAS f32x4*)dst = (f32x4){xv[0], xv[1], xv[2], xv[3]}; *(LAS f32x4*)(dst + 4) = (f32x4){xv[4], xv[5], xv[6], xv[7]};
                } else if (gi < 32) {
                    float tv[8];
#pragma unroll
                    for (int e = 0; e < 8; ++e) tv[e] = 1.f - 2.f * __builtin_amdgcn_rcpf(fast_exp(2.f * xv[e]) + 1.f);
                    u32x4 w; w.x = pk2(tv[0], tv[1]); w.y = pk2(tv[2], tv[3]); w.z = pk2(tv[4], tv[5]); w.w = pk2(tv[6], tv[7]);
                    *(LAS u32x4*)(TD + i * 72 + (gi - 24) * 8) = w;
                } else if (gi < 40) {
                    u32x4 w; w.x = pk2(xv[0], xv[1]); w.y = pk2(xv[2], xv[3]); w.z = pk2(xv[4], xv[5]); w.w = pk2(xv[6], xv[7]);
                    *(LAS u32x4*)(DA + i * 72 + (gi - 32) * 8) = w;
                } else {
                    float tv[8];
#pragma unroll
                    for (int e = 0; e < 8; ++e) tv[e] = sigmoidf_(xv[e]);
                    u32x4 w; w.x = pk2(tv[0], tv[1]); w.y = pk2(tv[2], tv[3]); w.z = pk2(tv[4], tv[5]); w.w = pk2(tv[6], tv[7]);
                    *(LAS u32x4*)(SG + i * 136 + (gi - 40) * 8) = w;
                }
            }
        }
        __syncthreads();
#ifndef ISSUE_LATE
        if (t0 + ntok < TT) RW_ISSUE(t0 + ntok, RW_CH);
#endif
        {
            f32x4 ad = {0.f, 0.f, 0.f, 0.f}, aa = ad, ag = ad;
#pragma unroll
            for (int ks = 0; ks < 2; ++ks) {
                bf16x8 fa = *(const LAS bf16x8*)(TD + (16 * mt + fi) * 72 + 32 * ks + 8 * fg);
                ad = __builtin_amdgcn_mfma_f32_16x16x32_bf16(fa, wdF[ks], ad, 0, 0, 0);
                bf16x8 fb = *(const LAS bf16x8*)(DA + (16 * mt + fi) * 72 + 32 * ks + 8 * fg);
                aa = __builtin_amdgcn_mfma_f32_16x16x32_bf16(fb, waF[ks], aa, 0, 0, 0);
            }
#pragma unroll
            for (int ks = 0; ks < 4; ++ks) {
                bf16x8 fc = *(const LAS bf16x8*)(SG + (16 * mt + fi) * 136 + 32 * ks + 8 * fg);
                ag = __builtin_amdgcn_mfma_f32_16x16x32_bf16(fc, wgF[ks], ag, 0, 0, 0);
            }
#pragma unroll
            for (int r = 0; r < 4; ++r) {
                const int tok = 16 * mt + 4 * fg + r, o = tok * 64 + nt * 16 + fi;
                const float xd = dbias + ad[r];
                const float wlog = -softplusf(-xd) - 0.5f;
                W[o] = fast_exp(-fast_exp(wlog));
                BV[o] = sigmoidf_(abias + aa[r]);
                G[o] = ag[r];
            }
        }
        __syncthreads();
        {
            const int o = tokC * 64 + ch4;
            const f32x4 k = *(const LAS f32x4*)(Kx + o), a = *(const LAS f32x4*)(BV + o), r = *(const LAS f32x4*)(R + o);
            f32x4 kk = k * kkv;
            const float ss = sum16((kk.x * kk.x + kk.y * kk.y) + (kk.z * kk.z + kk.w * kk.w));
            const float inv = 1.f / sqrtf(ss + 1e-12f);
            kk = kk * inv;
            const f32x4 km = k * (1.f + (a - 1.f) * kav);
            const f32x4 bb = r * km * rkv;
            const float bon = sum16((bb.x + bb.y) + (bb.z + bb.w));
            *(LAS f32x4*)(KKN + o) = -kk; *(LAS f32x4*)(BV + o) = kk * a; *(LAS f32x4*)(Kx + o) = km;
            if ((tid & 15) == 0) BON[tokC] = bon;
        }
        __syncthreads();
#ifdef ISSUE_LATE
        if (t0 + ntok < TT) RW_ISSUE(t0 + ntok, RW_CH);
#endif
        if (tid < 256) {
#ifndef SCAN_UNROLL
#define SCAN_UNROLL 2
#endif
#pragma unroll SCAN_UNROLL
            for (int i = 0; i < ntok; ++i) {
                const int o = i * 64 + kq * 8;
                const f32x4 n0 = *(const LAS f32x4*)(KKN + o), n1 = *(const LAS f32x4*)(KKN + o + 4);
                const f32x4 w0 = *(const LAS f32x4*)(W + o), w1 = *(const LAS f32x4*)(W + o + 4);
                const f32x4 b0 = *(const LAS f32x4*)(BV + o), b1 = *(const LAS f32x4*)(BV + o + 4);
                const f32x4 k0 = *(const LAS f32x4*)(Kx + o), k1 = *(const LAS f32x4*)(Kx + o + 4);
                const f32x4 r0 = *(const LAS f32x4*)(R + o), r1 = *(const LAS f32x4*)(R + o + 4);
                const f32x2 vpair = *(const LAS f32x2*)(V + i * 64 + 2 * vrow);
                const f32x2 nn[4] = {{n0.x, n0.y}, {n0.z, n0.w}, {n1.x, n1.y}, {n1.z, n1.w}};
                const f32x2 ww[4] = {{w0.x, w0.y}, {w0.z, w0.w}, {w1.x, w1.y}, {w1.z, w1.w}};
                const f32x2 bb[4] = {{b0.x, b0.y}, {b0.z, b0.w}, {b1.x, b1.y}, {b1.z, b1.w}};
                const f32x2 kk2[4] = {{k0.x, k0.y}, {k0.z, k0.w}, {k1.x, k1.y}, {k1.z, k1.w}};
                const f32x2 rr2[4] = {{r0.x, r0.y}, {r0.z, r0.w}, {r1.x, r1.y}, {r1.z, r1.w}};
                float sa[2], yy[2];
#pragma unroll
                for (int q = 0; q < 2; ++q) {
                    f32x2 s2 = S[q][0] * nn[0];
                    s2 = __builtin_elementwise_fma(S[q][1], nn[1], s2);
                    f32x2 s3 = S[q][2] * nn[2];
                    s3 = __builtin_elementwise_fma(S[q][3], nn[3], s3);
                    s2 = s2 + s3;
                    sa[q] = s2.x + s2.y;
                }
                sa[0] += dppf<0xB1>(sa[0]); sa[1] += dppf<0xB1>(sa[1]);
                sa[0] += dppf<0x4E>(sa[0]); sa[1] += dppf<0x4E>(sa[1]);
                sa[0] += dppf<0x141>(sa[0]); sa[1] += dppf<0x141>(sa[1]);
#pragma unroll
                for (int q = 0; q < 2; ++q) {
                    const f32x2 sa2 = {sa[q], sa[q]}, vv2 = {vpair[q], vpair[q]};
#pragma unroll
                    for (int j = 0; j < 4; ++j) S[q][j] = __builtin_elementwise_fma(S[q][j], ww[j], __builtin_elementwise_fma(sa2, bb[j], vv2 * kk2[j]));
                    f32x2 y2 = S[q][0] * rr2[0];
                    y2 = __builtin_elementwise_fma(S[q][1], rr2[1], y2);
                    f32x2 y3 = S[q][2] * rr2[2];
                    y3 = __builtin_elementwise_fma(S[q][3], rr2[3], y3);
                    y2 = y2 + y3;
                    yy[q] = y2.x + y2.y;
                }
                yy[0] += dppf<0xB1>(yy[0]); yy[1] += dppf<0xB1>(yy[1]);
                yy[0] += dppf<0x4E>(yy[0]); yy[1] += dppf<0x4E>(yy[1]);
                yy[0] += dppf<0x141>(yy[0]); yy[1] += dppf<0x141>(yy[1]);
                if (kq == 0) *(LAS f32x2*)(Y + i * 64 + 2 * vrow) = (f32x2){yy[0], yy[1]};
            }
        }
        __syncthreads();
        if (tokC < ntok && (t0 > 0 || b == 0)) {
            const int o = tokC * 64 + ch4;
            const f32x4 y = *(const LAS f32x4*)(Y + o);
            const float mean = sum16((y.x + y.y) + (y.z + y.w)) * (1.f / 64.f);
            const f32x4 d = y - mean;
            const float var = sum16((d.x * d.x + d.y * d.y) + (d.z * d.z + d.w * d.w)) * (1.f / 64.f);
            const float rs = 1.f / sqrtf(var + 6.4e-4f);
            f32x4 yn = d * rs * lgv + lbv;
            const f32x4 vv = *(const LAS f32x4*)(V + o), gg = *(const LAS f32x4*)(G + o);
            yn = (yn + BON[tokC] * vv) * gg;
            u32x2 w; w.x = pk2(yn.x, yn.y); w.y = pk2(yn.z, yn.w);
            *(u32x2*)(Yo + (size_t)tokrow(b, t0 + tokC) * DM + cC) = w;
        } else if (tokC < ntok) {
        }
        __syncthreads();
        t0 += ntok;
    }
}

constexpr int SB_KS = 0, SB_VT = 9216, SB_Q = 18432;
constexpr float SB_THR = 90.f;

__device__ __forceinline__ void sb_unit(const Params& p, int l, int b, int h, int qb, LAS unsigned char* lds, int tid) {
    const int wave = tid >> 6, lane = tid & 63, ql = lane & 15, g = lane >> 4;
    const bf16* P = (const bf16*)(p.ws + WS_RB);
    bf16* Yo = (bf16*)(p.ws + WS_RA);
    LAS bf16* Ks = (LAS bf16*)(lds + SB_KS); LAS bf16* Vt = (LAS bf16*)(lds + SB_VT);
    const int tq = (qb < 0 ? 0 : NMETA + 128 * qb) + 16 * wave + ql;
    const bool wave_valid = (qb >= 0) || (wave == 0);
    const int tqc = wave_valid ? tq : 0;
    bf16x8 qF[2];
    {
        const bf16* qp = P + (size_t)tokrow(b, tqc) * INC + C_Q + h * 64 + 8 * g;
        qF[0] = ldnt<bf16x8>(qp); qF[1] = ldnt<bf16x8>(qp + 32);
    }
    unsigned P01, P23; const unsigned ONES = 0x3F803F80u;
    { const unsigned p0 = (4 * g + 0 > ql) ? 0x3F80u : 0u, p1 = (4 * g + 1 > ql) ? 0x3F80u : 0u, p2 = (4 * g + 2 > ql) ? 0x3F80u : 0u, p3 = (4 * g + 3 > ql) ? 0x3F80u : 0u;
      P01 = p0 | (p1 << 16); P23 = p2 | (p3 << 16); }
    const bf16x8 FA = __builtin_bit_cast(bf16x8, (u32x4){P01, P23, ONES, ONES});
    const bf16x8 FB = __builtin_bit_cast(bf16x8, (u32x4){0u, 0u, P01, P23});
    const bf16x8 F1 = __builtin_bit_cast(bf16x8, (u32x4){ONES, ONES, ONES, ONES});
    f32x4 O[4];
#pragma unroll
    for (int d = 0; d < 4; ++d) O[d] = (f32x4){0.f, 0.f, 0.f, 0.f};
    float carry = 0.f;
    const int wave_tq_max = (qb < 0 ? 0 : NMETA + 128 * qb) + 16 * wave + 15;
    const int i_hi = qb < 0 ? 0 : 2 * qb + 2;
    const int kap = tid >> 3, piece = tid & 7;
    const int slot = (kap >> 5) * 32 + ((kap >> 2) & 3) * 8 + ((kap >> 4) & 1) * 4 + (kap & 3);
    bool wave_done = !wave_valid;
    volatile LAS unsigned* orw = (volatile LAS unsigned*)(lds + SB_Q + 16);
    if (tid < 2) orw[tid] = 0u;
    int nit = 0;
    for (int it = i_hi; it >= 0; --it, ++nit) {
        const int tk0 = NMETA + 64 * (it - 1);
        {
            const int tk = tk0 + kap;
            u32x4 kv = {0u, 0u, 0u, 0u}, vv = kv;
            if (tk >= 0) { const bf16* rp = P + (size_t)tokrow(b, tk) * INC + h * 64 + piece * 8; kv = ldnt<u32x4>(rp + C_SK); vv = ldnt<u32x4>(rp + C_SV); }
            *(LAS u32x4*)(Ks + kap * 72 + piece * 8) = kv;
            const unsigned vu[4] = {vv.x, vv.y, vv.z, vv.w};
#pragma unroll
            for (int e = 0; e < 4; ++e) { Vt[(piece * 8 + 2 * e) * 72 + slot] = (bf16)(vu[e] & 0xffffu); Vt[(piece * 8 + 2 * e + 1) * 72 + slot] = (bf16)(vu[e] >> 16); }
        }
        __syncthreads();
        if (!wave_done && tk0 < wave_tq_max) {
            f32x4 s[4];
#pragma unroll
            for (int m = 0; m < 4; ++m) {
                s[m] = (f32x4){0.f, 0.f, 0.f, 0.f};
#pragma unroll
                for (int ks = 0; ks < 2; ++ks) {
                    bf16x8 a = *(const LAS bf16x8*)(Ks + (16 * m + ql) * 72 + 32 * ks + 8 * g);
                    s[m] = __builtin_amdgcn_mfma_f32_16x16x32_bf16(a, qF[ks], s[m], 0, 0, 0);
                }
            }
            float z[4][4], sp[4][4]; bool val[4][4];
            unsigned hi[4][2], lo[4][2];
#pragma unroll
            for (int m = 0; m < 4; ++m) {
#pragma unroll
                for (int r = 0; r < 4; ++r) {
                    const int tk = tk0 + 16 * m + 4 * g + r;
                    val[m][r] = (tk >= 0) && (tk < tq);
                    z[m][r] = s[m][r] * 0.125f;
                    sp[m][r] = val[m][r] ? softplusf(z[m][r]) : 0.f;
                }
#pragma unroll
                for (int r2 = 0; r2 < 2; ++r2) {
                    const unsigned hh = pk2(sp[m][2 * r2], sp[m][2 * r2 + 1]);
                    hi[m][r2] = hh;
                    lo[m][r2] = pk2(sp[m][2 * r2] - bflo(hh), sp[m][2 * r2 + 1] - bfhi(hh));
                }
            }
            const bf16x8 hF0 = __builtin_bit_cast(bf16x8, (u32x4){hi[0][0], hi[0][1], hi[1][0], hi[1][1]});
            const bf16x8 hF1 = __builtin_bit_cast(bf16x8, (u32x4){hi[2][0], hi[2][1], hi[3][0], hi[3][1]});
            const bf16x8 lF0 = __builtin_bit_cast(bf16x8, (u32x4){lo[0][0], lo[0][1], lo[1][0], lo[1][1]});
            const bf16x8 lF1 = __builtin_bit_cast(bf16x8, (u32x4){lo[2][0], lo[2][1], lo[3][0], lo[3][1]});
            f32x4 cum[4];
            const f32x4 zero4 = {0.f, 0.f, 0.f, 0.f};
            cum[0] = __builtin_amdgcn_mfma_f32_16x16x32_bf16(FA, hF0, zero4, 0, 0, 0);
            cum[0] = __builtin_amdgcn_mfma_f32_16x16x32_bf16(FA, lF0, cum[0], 0, 0, 0);
            cum[0] = __builtin_amdgcn_mfma_f32_16x16x32_bf16(F1, hF1, cum[0], 0, 0, 0);
            cum[0] = __builtin_amdgcn_mfma_f32_16x16x32_bf16(F1, lF1, cum[0], 0, 0, 0);
            cum[1] = __builtin_amdgcn_mfma_f32_16x16x32_bf16(FB, hF0, zero4, 0, 0, 0);
            cum[1] = __builtin_amdgcn_mfma_f32_16x16x32_bf16(FB, lF0, cum[1], 0, 0, 0);
            cum[1] = __builtin_amdgcn_mfma_f32_16x16x32_bf16(F1, hF1, cum[1], 0, 0, 0);
            cum[1] = __builtin_amdgcn_mfma_f32_16x16x32_bf16(F1, lF1, cum[1], 0, 0, 0);
            cum[2] = __builtin_amdgcn_mfma_f32_16x16x32_bf16(FA, hF1, zero4, 0, 0, 0);
            cum[2] = __builtin_amdgcn_mfma_f32_16x16x32_bf16(FA, lF1, cum[2], 0, 0, 0);
            cum[3] = __builtin_amdgcn_mfma_f32_16x16x32_bf16(FB, hF1, zero4, 0, 0, 0);
            cum[3] = __builtin_amdgcn_mfma_f32_16x16x32_bf16(FB, lF1, cum[3], 0, 0, 0);
            unsigned af[4][2];
#pragma unroll
            for (int m = 0; m < 4; ++m) {
                float av[4];
#pragma unroll
                for (int r = 0; r < 4; ++r) { const float la = (z[m][r] - sp[m][r]) - cum[m][r] - carry; av[r] = val[m][r] ? fast_exp(la) : 0.f; }
                af[m][0] = pk2(av[0], av[1]); af[m][1] = pk2(av[2], av[3]);
            }
            const bf16x8 aF0 = __builtin_bit_cast(bf16x8, (u32x4){af[0][0], af[0][1], af[1][0], af[1][1]});
            const bf16x8 aF1 = __builtin_bit_cast(bf16x8, (u32x4){af[2][0], af[2][1], af[3][0], af[3][1]});
            const float tot = __shfl(cum[0][0] + sp[0][0], ql);
            carry += tot;
#pragma unroll
            for (int d = 0; d < 4; ++d) {
                bf16x8 v0 = *(const LAS bf16x8*)(Vt + (16 * d + ql) * 72 + 8 * g);
                bf16x8 v1 = *(const LAS bf16x8*)(Vt + (16 * d + ql) * 72 + 32 + 8 * g);
                O[d] = __builtin_amdgcn_mfma_f32_16x16x32_bf16(v0, aF0, O[d], 0, 0, 0);
                O[d] = __builtin_amdgcn_mfma_f32_16x16x32_bf16(v1, aF1, O[d], 0, 0, 0);
            }
            if (__all(carry > SB_THR)) wave_done = true;
        }
        if (lane == 0 && !wave_done && it > 0) orw[nit & 1] = 1u;
        __syncthreads();
        const unsigned more = orw[nit & 1];
        if (tid == 0) orw[(nit + 1) & 1] = 0u;
        if (!more) break;
    }
    if (wave_valid && (qb >= 0 || b == 0)) {
        float ss = 0.f;
#pragma unroll
        for (int d = 0; d < 4; ++d) ss += (O[d].x * O[d].x + O[d].y * O[d].y) + (O[d].z * O[d].z + O[d].w * O[d].w);
        ss += __shfl_xor(ss, 16); ss += __shfl_xor(ss, 32);
        const float inv = 1.f / sqrtf(ss * (1.f / 64.f) + 1e-6f);
        bf16* yp = Yo + (size_t)tokrow(b, tq) * DM + 512 + h * 64;
        const float* gp = p.sb_gain + l * 512 + h * 64;
#pragma unroll
        for (int d = 0; d < 4; ++d) {
            const f32x4 gg = *(const f32x4*)(gp + 16 * d + 4 * g);
            const f32x4 v = O[d] * inv * gg;
            u32x2 w; w.x = pk2(v.x, v.y); w.y = pk2(v.z, v.w);
            *(u32x2*)(yp + 16 * d + 4 * g) = w;
        }
    }
}

__device__ __forceinline__ void mix_phase(const Params& p_in, int l, LAS unsigned char* lds, int cslot = -1) {
#if defined(__HIP_DEVICE_COMPILE__)
    const Params p = *kargs();
#else
    const Params& p = p_in;
#endif
    const int tid = ltid();
    const int G = gridDim.x;
#ifdef CHAINS_HIGH
    for (int c = (int)blockIdx.x - (G - NB * 8); c < NB * 8; c += G) if (c >= 0) rwkv_chain(
#else
    for (int c = blockIdx.x; c < NB * 8; c += G) rwkv_chain(
#endif
    p, l, c >> 3, c & 7, lds, tid);
    unsigned* ctr = (unsigned*)(p.ws + WS_CTL) + 64 * (cslot < 0 ? l + 1 : cslot);
    volatile LAS unsigned* qw = (volatile LAS unsigned*)(lds + SB_Q);
    for (;;) {
        __syncthreads();
        if (tid == 0) qw[0] = atomicAdd(ctr, 1u);
        __syncthreads();
        const unsigned u = qw[0];
        if (u >= 2048u + 8u) break;
        if (u < 2048u) { const int qb = 15 - (int)(u >> 7), bh = (int)(u & 127u); sb_unit(p, l, bh >> 3, bh & 7, qb, lds, tid); }
        else sb_unit(p, l, 0, (int)(u - 2048u), -1, lds, tid);
    }
}


#ifdef DIAG_W
__device__ __forceinline__ bool check_win(const Params& p) {
    const int t = ltid(), xl = blockIdx.x >> 3, nxl = gridDim.x >> 3;
    bool bad = false;
    for (int l = 0; l < NL; ++l) {
        const float* W = p.w_in + (size_t)l * DM * INC; const bf16* WT = (const bf16*)(p.ws + WS_WIN + l * SZ_WIN);
        for (int g = xl * NTHR + t; g < INC * (DM / 8); g += nxl * NTHR) {
            const int n = g / (DM / 8), k0 = (g % (DM / 8)) * 8;
            const u32x4 v = *(const u32x4*)(WT + (size_t)n * DM + k0);
            const unsigned vv[4] = {v.x, v.y, v.z, v.w};
#pragma unroll
            for (int j = 0; j < 4; ++j) { const unsigned e = pk2(W[(size_t)(k0 + 2 * j) * INC + n], W[(size_t)(k0 + 2 * j + 1) * INC + n]); bad |= (e != vv[j]); }
        }
    }
    return __any(bad);
}
#endif

#define XB_TMO      128
#define XB_XCNT(j)  (256  + 64 * (j))
#define XB_XSUB(j)  (1280 + 64 * (j))
#define XB_XGEN(j)  (2304 + 64 * (j))
#define XB_TOP      3328
#define XB_TOPGEN   3392
#define XCD_BAR_WORDS 3456
#define XB_SPIN_CAP (1u << 18)

__device__ __forceinline__ unsigned xb_ld(unsigned* p)              { return __hip_atomic_load(p, __ATOMIC_RELAXED, __HIP_MEMORY_SCOPE_AGENT); }
__device__ __forceinline__ unsigned xb_add(unsigned* p, unsigned v) { return __hip_atomic_fetch_add(p, v, __ATOMIC_RELAXED, __HIP_MEMORY_SCOPE_AGENT); }
__device__ __forceinline__ unsigned xb_xcc_id() { return (unsigned)__builtin_amdgcn_s_getreg((3 << 11) | 20) & 0xFu; }
#define XB_SPIN(cond, bar) do { unsigned _sp = 0; while (cond) { __builtin_amdgcn_s_sleep(1); \
    if ((++_sp & 255u) == 0u) { if (xb_ld(&(bar)[XB_TMO])) break; if (_sp > XB_SPIN_CAP) { atomicAdd(&(bar)[XB_TMO], 1u); break; } } } } while (0)

struct XcdBarrier {
    unsigned* bar; unsigned x;
    volatile LAS unsigned* st;
};

__device__ __forceinline__ XcdBarrier xcd_barrier_post(unsigned* bar, volatile LAS unsigned* st) {
    XcdBarrier b; b.bar = bar; b.x = xb_xcc_id(); b.st = st;
    if (threadIdx.x == 0) (void)xb_add(&bar[XB_XCNT(b.x)], 1u);
    return b;
}
__device__ __forceinline__ void xcd_barrier_complete(unsigned* bar, unsigned x, unsigned& nloc, unsigned& nx) {
    const unsigned G = gridDim.x * gridDim.y * gridDim.z;
    unsigned sum, cnt, mine, sp = 0u;
    for (;;) {
        sum = 0u; cnt = 0u; mine = 0u;
#pragma unroll
        for (unsigned j = 0; j < 16; ++j) { const unsigned c = xb_ld(&bar[XB_XCNT(j)]); sum += c; cnt += (c > 0u) ? 1u : 0u; mine = (j == x) ? c : mine; }
        if (sum == G) break;
        __builtin_amdgcn_s_sleep(1);
        if ((++sp & 255u) == 0u) { if (xb_ld(&bar[XB_TMO])) break; if (sp > XB_SPIN_CAP) { atomicAdd(&bar[XB_TMO], 1u); break; } }
    }
    nloc = mine > 0u ? mine : 1u; nx = cnt > 0u ? cnt : 1u;
}

__device__ __forceinline__ void xcd_barrier(const XcdBarrier& b) {
    asm volatile("s_waitcnt vmcnt(0)" ::: "memory");
    __syncthreads();
    if (threadIdx.x == 0) {
        unsigned* bar = b.bar;
        __builtin_amdgcn_s_waitcnt(0);
        unsigned nloc = b.st[0], nx = b.st[1];
        if (nloc == 0u) { xcd_barrier_complete(bar, b.x, nloc, nx); b.st[0] = nloc; b.st[1] = nx; }
        const unsigned old = xb_add(&bar[XB_XSUB(b.x)], 1u);
        const unsigned gen = old / nloc;
        if (old + 1u == (gen + 1u) * nloc) {
            __builtin_amdgcn_fence(__ATOMIC_RELEASE, "agent");
            asm volatile("s_waitcnt vmcnt(0)" ::: "memory");
            const unsigned og = xb_add(&bar[XB_TOP], 1u);
            const unsigned tg = og / nx;
            if (og + 1u == (tg + 1u) * nx) xb_add(&bar[XB_TOPGEN], 1u);
            else XB_SPIN(xb_ld(&bar[XB_TOPGEN]) == tg, bar);
            __builtin_amdgcn_fence(__ATOMIC_ACQUIRE, "agent");
            xb_add(&bar[XB_XGEN(b.x)], 1u);
            asm volatile("s_waitcnt vmcnt(0)" ::: "memory");
        } else {
            XB_SPIN(xb_ld(&bar[XB_XGEN(b.x)]) == gen, bar);
            __builtin_amdgcn_fence(__ATOMIC_ACQUIRE, "agent");
            asm volatile("s_waitcnt vmcnt(0)" ::: "memory");
        }
    }
    __syncthreads();
}

template <int N, int K, int ACT>
__device__ __forceinline__ void gemm_call(const bf16* A, const bf16* Bt, bf16* O, LAS unsigned char* lds) {
    pg8::Gemm gm{A, Bt, MR, N, K};
    pg8::StaticOrder S; S.init(MR, N, gridDim.x, blockIdx.x);
    EpiOut E{O, N, ACT};
    pg8::gemm_phase<EpiOut, pg8::StaticOrder, true, true>(lds, gm, S, E);
    { const int t = ltid(); meta_gemm(A, Bt, N, K, O, ACT, blockIdx.x * NWAVES + (t >> 6), gridDim.x * NWAVES, t & 63); }
}

template <int K>
__device__ __forceinline__ void gemm_call_f32(const bf16* A, const bf16* Bt, float* lo, float* hi, LAS unsigned char* lds) {
    pg8::Gemm gm{A, Bt, MR, DM, K};
    pg8::StaticOrder S; S.init(MR, DM, gridDim.x, blockIdx.x);
    EpiF32Split E{lo, hi};
    pg8::gemm_phase<EpiF32Split, pg8::StaticOrder, true, true>(lds, gm, S, E);
    { const int t = ltid(); meta_gemm(A, Bt, DM, K, nullptr, 0, blockIdx.x * NWAVES + (t >> 6), gridDim.x * NWAVES, t & 63, lo, hi); }
}

__global__ void __launch_bounds__(NTHR, 2) trunk_fwd(Params p_unused) {
#if defined(__HIP_DEVICE_COMPILE__)
#define KP (kargs())
    extern __shared__ __attribute__((aligned(16))) unsigned char shm[];
    LAS unsigned char* lds = (LAS unsigned char*)shm;
    cg::grid_group grid = cg::this_grid();
#ifndef POST_SLEEP
#define POST_SLEEP 0
#endif
#ifdef USE_XCD_BARRIER
    volatile LAS unsigned* bst = (volatile LAS unsigned*)(lds + 131072 + 64);
    if (threadIdx.x < 2) bst[threadIdx.x] = 0u;
    __syncthreads();
    (void)xcd_barrier_post((unsigned*)(KP->ws + WS_BAR), bst);
    grid.sync();
#define GSYNC() do { XcdBarrier xb_; xb_.bar = (unsigned*)(KP->ws + WS_BAR); xb_.x = xb_xcc_id(); xb_.st = (volatile LAS unsigned*)(lds + 131072 + 64); xcd_barrier(xb_); } while (0)
#else
#define GSYNC() do { asm volatile("s_waitcnt vmcnt(0)" ::: "memory"); __threadfence(); asm volatile("s_waitcnt vmcnt(0)" ::: "memory"); grid.sync(); __threadfence(); for (int s_ = 0; s_ < POST_SLEEP; ++s_) __builtin_amdgcn_s_sleep(127); } while (0)
#endif
#define RA ((bf16*)(KP->ws + WS_RA))
#define RB ((bf16*)(KP->ws + WS_RB))
#define HM ((float*)(KP->ws + WS_HM))
    { unsigned* ctl0 = (unsigned*)(KP->ws + WS_CTL); if (blockIdx.x == 0 && threadIdx.x < 8) ctl0[64 * threadIdx.x] = 0u; }
    { const Params pc_ = *KP; conv_phase(pc_, lds); }
    norm_phase(nullptr, nullptr, nullptr, KP->x, KP->meta, KP->out, HM, KP->g_pre_mix, RA);
    GSYNC();
#ifdef DIAG_W
    const bool wbad = check_win(p);
#endif
    for (int l = 0; l < NL; ++l) {
        for (int gi = 0; gi < 4; ++gi) {
            if (gi == 1) {
                #ifdef PROBE_MIX2
                for (int rep = 0; rep < 2; ++rep) { if (rep) GSYNC(); const Params pm_ = *KP; mix_phase(pm_, l, lds, rep ? (l == 0 ? 0 : 4 + l) : -1); }
#else
                { const Params pm_ = *KP; mix_phase(pm_, l, lds); }
#endif
                GSYNC();
            }
            if (gi == 0) gemm_call<INC, DM, 0>(RA, (const bf16*)(KP->ws + WS_WIN + l * SZ_WIN), RB, lds);
            else if (gi == 1) gemm_call_f32<DM>(RA, (const bf16*)(KP->ws + WS_WOUT + l * SZ_WOUT), (float*)RB, (float*)RB + (size_t)MT * 512, lds);
            else if (gi == 2) gemm_call<DFF, DM, 1>(RA, (const bf16*)(KP->ws + WS_WUP + l * SZ_WUP), RB, lds);
            else gemm_call_f32<DFF>(RB, (const bf16*)(KP->ws + WS_WDN + l * SZ_WDN), (float*)RA, (float*)(KP->ws + WS_T2HI), lds);
            GSYNC();
            if (gi == 1) {
                norm_phase((const float*)RB, (const float*)RB + (size_t)MT * 512, KP->g_post_mix + l * DM, l == 0 ? KP->x : KP->out, l == 0 ? KP->meta : HM, KP->out, HM, KP->g_pre_ffn + l * DM, RA);
                GSYNC();
            } else if (gi == 3) {
                norm_phase((const float*)RA, (const float*)(KP->ws + WS_T2HI), KP->g_post_ffn + l * DM, KP->out, HM, KP->out, HM, l + 1 < NL ? KP->g_pre_mix + (l + 1) * DM : nullptr, RA);
                if (l + 1 < NL) GSYNC();
            }
        }
    }
#ifdef DIAG_W
    GSYNC();
    if (wbad && threadIdx.x == 0) KP->out[blockIdx.x] += 100000.f;
#endif
#undef RA
#undef RB
#undef HM
#endif
}

extern "C" void kernel_launch(void* const* d_in, const int* in_sizes, int n_in, void* d_out, int out_size, void* d_ws, size_t ws_size, hipStream_t stream) {
    static int grid = 0;
    if (grid == 0) {
        if (n_in != 22 || ws_size < WS_END) { fprintf(stderr, "kernel_launch: unexpected n_in %d / ws_size %zu (need %zu)\n", n_in, ws_size, (size_t)WS_END); grid = -1; return; }
        int dev = 0, cus = 0, per_cu = 0;
        hipGetDevice(&dev);
        hipDeviceGetAttribute(&cus, hipDeviceAttributeMultiprocessorCount, dev);
        if (hipFuncSetAttribute((const void*)trunk_fwd, hipFuncAttributeMaxDynamicSharedMemorySize, LDS_BYTES) != hipSuccess) { fprintf(stderr, "kernel_launch: hipFuncSetAttribute failed\n"); grid = -1; return; }
        if (hipOccupancyMaxActiveBlocksPerMultiprocessor(&per_cu, (const void*)trunk_fwd, NTHR, LDS_BYTES) != hipSuccess || per_cu < 1) { fprintf(stderr, "kernel_launch: occupancy query says %d\n", per_cu); per_cu = 1; }
        (void)hipGetLastError();
        grid = cus * per_cu;
        fprintf(stderr, "kernel_launch: grid %d (cus %d x %d)\n", grid, cus, per_cu);
    }
    if (grid < 0) return;
    if (hipMemsetAsync((char*)d_ws + WS_CTL, 0, WS_HM, stream) != hipSuccess) { fprintf(stderr, "kernel_launch: memset failed\n"); return; }
    Params p{};
    const float** f = (const float**)&p;
    for (int i = 0; i < 22; ++i) f[i] = (const float*)d_in[i];
    p.out = (float*)d_out; p.ws = (unsigned char*)d_ws;
    void* args[] = {&p};
    hipError_t e = hipLaunchCooperativeKernel((const void*)trunk_fwd, dim3(grid), dim3(NTHR), args, LDS_BYTES, stream);
    if (e != hipSuccess) fprintf(stderr, "cooperative launch failed: %s (grid %d)\n", hipGetErrorString(e), grid);
}
```

```cpp
#define SCAN_UNROLL 2
#define USE_XCD_BARRIER 1
#include <hip/hip_runtime.h>
#include <hip/hip_cooperative_groups.h>
#include <cstdio>
#include <cstdint>
namespace cg = cooperative_groups;
namespace pg8 {
#define PG8_LAS __attribute__((address_space(3)))
#ifndef PG8_AUX
#define PG8_AUX 2
#endif
typedef unsigned short bf16_t;
typedef short bf16x8 __attribute__((ext_vector_type(8)));
typedef float f32x4 __attribute__((ext_vector_type(4)));
typedef unsigned u32x4 __attribute__((ext_vector_type(4)));
constexpr int BM = 256, BK = 64, HALF = 128, HTB = HALF * BK * 2  , STAGE_BYTES = 8 * HTB, NXCD = 8, WGM = 8;

__host__ __device__ __forceinline__ int lds_byte(int r, int c) { const int st = (r >> 4) * 2 + (c >> 5), rr = r & 15, cc = c & 31, ob = rr * 64 + cc * 2; return st * 1024 + (ob ^ (((ob >> 9) & 1) << 5)); }
__host__ __device__ __forceinline__ void stage_rc(int b, int& R, int& C) { const int st = b / 1024, sb = b % 1024, swz = sb ^ (((sb >> 9) & 1) << 5); R = (st >> 1) * 16 + swz / 64; C = (st & 1) * 32 + (swz % 64) / 2; }
__host__ __device__ __forceinline__ int perm32(int rho) { const int n = rho >> 4, i = rho & 15; return 8 * (i >> 2) + 4 * n + (i & 3); }

struct Unit { int pm, pn; };
struct Gemm { const bf16_t* A; const bf16_t* Bt; int M, N, K; };

struct StaticOrder {
    int nM, nN, nwg, G, c;
    __host__ __device__ void init(int M, int N, int G_, int c_) { nM = M / BM; nN = N / BM; nwg = nM * nN; G = G_; c = c_; }
    __host__ __device__ bool next(int i, Unit& u) const {
        const long L = (long)i * G + c; if (L >= nwg) return false;
        int wgid = (int)L; { const int q = nwg / NXCD, r = nwg % NXCD, xcd = wgid % NXCD, off = wgid / NXCD; wgid = (xcd < r ? xcd * (q + 1) : r * (q + 1) + (xcd - r) * q) + off; }
        const int nig = WGM * nN, gid = wgid / nig, fm = gid * WGM, gsz = (nM - fm) < WGM ? (nM - fm) : WGM;
        u.pm = fm + ((wgid % nig) % gsz); u.pn = (wgid % nig) / gsz; return true;
    }
    __device__ __forceinline__ void a_ready(const Unit&) const {}
    __device__ __forceinline__ void done(const Unit&) const {}
};

__device__ __forceinline__ unsigned cvt_pk_bf16(float lo, float hi) { unsigned r; asm volatile("v_cvt_pk_bf16_f32 %0, %1, %2" : "=v"(r) : "v"(lo), "v"(hi)); return r; }
typedef float f32x2 __attribute__((ext_vector_type(2)));
template <class Epi, class Sched, bool ALIGN_EPI = false, bool SP2 = false>
__device__ __forceinline__ void gemm_phase(PG8_LAS unsigned char* lds, const Gemm g, const Sched& S, const Epi& E) {
    int tid_ = threadIdx.x; asm volatile("" : "+v"(tid_));
    const int tid = tid_, wid = __builtin_amdgcn_readfirstlane(tid >> 6), lane = tid & 63, wr = wid >> 2, wc = wid & 3, fr = lane & 15, fq = lane >> 4;
    const int K = g.K, nt = K / BK;
    unsigned voffA[2], voffB[2];
#pragma unroll
    for (int i = 0; i < 2; ++i) { int R, C; stage_rc(tid * 16 + i * 8192, R, C); const int Rb = Epi::PERM ? ((R & ~31) + perm32(R & 31)) : R;
        voffA[i] = (unsigned)(R * K + C) * 2u; voffB[i] = (unsigned)(Rb * K + C) * 2u; }
    const size_t kstep = (size_t)(BK * 2);
    const size_t hstep = (size_t)HALF * K * 2;
    const size_t tstep = 2 * hstep;
    const unsigned ldsw = (unsigned)wid * 1024u;
    const int aoff = lds_byte(wr * 64 + fr, fq * 8), boff = lds_byte(wc * 32 + fr, fq * 8);
#define PG8_SA(b, h) (((b) * 2 + (h)) * HTB)
#define PG8_SB(b, h) ((4 + (b) * 2 + (h)) * HTB)
#define PG8_STAGE(bufoff, gbase, voff) do { _Pragma("unroll") for (int _i = 0; _i < 2; ++_i) \
        __builtin_amdgcn_global_load_lds((const unsigned*)((const char*)(gbase) + (voff)[_i]), (PG8_LAS unsigned*)(lds + (bufoff) + ldsw + _i * 8192), 16, 0, 0); } while (0)
#define PG8_LDA(dst, b, h) do { _Pragma("unroll") for (int m = 0; m < 4; ++m) _Pragma("unroll") for (int k = 0; k < 2; ++k) dst[m][k] = *(const PG8_LAS bf16x8*)(lds + PG8_SA(b, h) + aoff + m * 2048 + k * 1024); } while (0)
#define PG8_LDB(dst, b, h) do { _Pragma("unroll") for (int n = 0; n < 2; ++n) _Pragma("unroll") for (int k = 0; k < 2; ++k) dst[n][k] = *(const PG8_LAS bf16x8*)(lds + PG8_SB(b, h) + boff + n * 2048 + k * 1024); } while (0)
#define PG8_MMA(ai, bj, At, Bt) do { __builtin_amdgcn_s_setprio(1); _Pragma("unroll") for (int m = 0; m < 4; ++m) _Pragma("unroll") for (int n = 0; n < 2; ++n) _Pragma("unroll") for (int k = 0; k < 2; ++k) \
        acc[ai][bj][m][n] = __builtin_amdgcn_mfma_f32_16x16x32_bf16(Bt[n][k], At[m][k], acc[ai][bj][m][n], 0, 0, 0); __builtin_amdgcn_s_setprio(0); } while (0)
#define PG8_WAIT_V(n) asm volatile("s_waitcnt vmcnt(" #n ")" ::: "memory")
#define PG8_WAIT_L(n) asm volatile("s_waitcnt lgkmcnt(" #n ")" ::: "memory")
#define PG8_BAR __builtin_amdgcn_s_barrier()
#define PG8_SCHED __builtin_amdgcn_sched_barrier(0)
    Unit cur, nxt; int ui = 0;
    if (!S.next(0, cur)) return;
    f32x4 acc[2][2][4][2];
#pragma unroll
    for (int a = 0; a < 2; ++a)
#pragma unroll
        for (int b = 0; b < 2; ++b)
#pragma unroll
            for (int m = 0; m < 4; ++m)
#pragma unroll
                for (int n = 0; n < 2; ++n) acc[a][b][m][n] = (f32x4){0.f, 0.f, 0.f, 0.f};
    bf16x8 At[4][2], B0[2][2], B1[2][2];
    const char* cA = (const char*)g.A + (size_t)cur.pm * tstep; const char* cB = (const char*)g.Bt + (size_t)cur.pn * tstep;
    S.a_ready(cur);
    if constexpr (SP2) {
        PG8_STAGE(PG8_SB(0, 0), cB, voffB); PG8_STAGE(PG8_SB(0, 1), cB + hstep, voffB); PG8_STAGE(PG8_SA(0, 0), cA, voffA); PG8_STAGE(PG8_SA(0, 1), cA + hstep, voffA);
        if (wr == 1) PG8_BAR;
        PG8_WAIT_V(2); PG8_BAR;
        PG8_STAGE(PG8_SB(1, 0), cB + kstep, voffB); PG8_STAGE(PG8_SA(1, 0), cA + kstep, voffA); PG8_STAGE(PG8_SB(1, 1), cB + hstep + kstep, voffB);
        PG8_WAIT_V(6); PG8_BAR;
    } else {
        PG8_STAGE(PG8_SB(0, 0), cB, voffB); PG8_STAGE(PG8_SA(0, 0), cA, voffA); PG8_STAGE(PG8_SB(0, 1), cB + hstep, voffB); PG8_STAGE(PG8_SA(0, 1), cA + hstep, voffA);
        if (wr == 1) PG8_BAR;
        PG8_WAIT_V(4); PG8_BAR;
        PG8_STAGE(PG8_SB(1, 0), cB + kstep, voffB); PG8_STAGE(PG8_SA(1, 0), cA + kstep, voffA); PG8_STAGE(PG8_SB(1, 1), cB + hstep + kstep, voffB);
        PG8_WAIT_V(6); PG8_BAR;
    }
    for (;;) {
        const bool has_next = S.next(ui + 1, nxt);
        const char* nA = has_next ? (const char*)g.A + (size_t)nxt.pm * tstep : cA; const char* nB = has_next ? (const char*)g.Bt + (size_t)nxt.pn * tstep : cB;
        for (int t = 0; t < nt; t += 2) {
            const bool last = (t == nt - 2);
            const char* a1 = cA + (size_t)(t + 1) * kstep;
            const char* a2 = last ? nA : cA + (size_t)(t + 2) * kstep; const char* b2 = last ? nB : cB + (size_t)(t + 2) * kstep;
            const char* a3 = a2 + kstep; const char* b3 = b2 + kstep;
            if (last && has_next) S.a_ready(nxt);
            if constexpr (SP2) {
            PG8_LDB(B0, 0, 0); PG8_LDB(B1, 0, 1); PG8_SCHED; PG8_LDA(At, 0, 0); PG8_STAGE(PG8_SA(1, 1), a1 + hstep, voffA);
            PG8_WAIT_V(8); PG8_WAIT_L(0); PG8_BAR; PG8_MMA(0, 0, At, B0); PG8_MMA(0, 1, At, B1); PG8_BAR; PG8_SCHED;
            PG8_LDA(At, 0, 1); PG8_STAGE(PG8_SB(0, 0), b2, voffB); PG8_STAGE(PG8_SB(0, 1), b2 + hstep, voffB); PG8_STAGE(PG8_SA(0, 0), a2, voffA);
            PG8_WAIT_V(8); PG8_WAIT_L(0); PG8_BAR; PG8_MMA(1, 0, At, B0); PG8_MMA(1, 1, At, B1); PG8_BAR; PG8_SCHED;
            PG8_LDB(B0, 1, 0); PG8_LDB(B1, 1, 1); PG8_SCHED; PG8_LDA(At, 1, 0); PG8_STAGE(PG8_SA(0, 1), a2 + hstep, voffA);
            PG8_WAIT_V(8); PG8_WAIT_L(0); PG8_BAR; PG8_MMA(0, 0, At, B0); PG8_MMA(0, 1, At, B1); PG8_BAR; PG8_SCHED;
            PG8_LDA(At, 1, 1); PG8_STAGE(PG8_SB(1, 0), b3, voffB); PG8_STAGE(PG8_SB(1, 1), b3 + hstep, voffB); PG8_STAGE(PG8_SA(1, 0), a3, voffA);
            PG8_WAIT_V(8); PG8_WAIT_L(0); PG8_BAR; PG8_MMA(1, 0, At, B0); PG8_MMA(1, 1, At, B1); PG8_BAR; PG8_SCHED;
            } else {
            PG8_LDB(B0, 0, 0); PG8_SCHED; PG8_LDA(At, 0, 0); PG8_STAGE(PG8_SA(1, 1), a1 + hstep, voffA);
            PG8_WAIT_L(8); PG8_BAR; PG8_WAIT_L(0); PG8_MMA(0, 0, At, B0); PG8_BAR; PG8_SCHED;
            PG8_LDB(B1, 0, 1); PG8_STAGE(PG8_SB(0, 0), b2, voffB);
            PG8_BAR; PG8_WAIT_L(0); PG8_MMA(0, 1, At, B1); PG8_BAR;
            PG8_LDA(At, 0, 1); PG8_STAGE(PG8_SA(0, 0), a2, voffA);
            PG8_BAR; PG8_WAIT_L(0); PG8_MMA(1, 0, At, B0); PG8_BAR; PG8_SCHED;
            PG8_STAGE(PG8_SB(0, 1), b2 + hstep, voffB);
            PG8_WAIT_V(6); PG8_BAR; PG8_MMA(1, 1, At, B1); PG8_BAR;
            PG8_LDB(B0, 1, 0); PG8_SCHED; PG8_LDA(At, 1, 0); PG8_STAGE(PG8_SA(0, 1), a2 + hstep, voffA);
            PG8_WAIT_L(8); PG8_BAR; PG8_WAIT_L(0); PG8_MMA(0, 0, At, B0); PG8_BAR; PG8_SCHED;
            PG8_LDB(B1, 1, 1); PG8_STAGE(PG8_SB(1, 0), b3, voffB);
            PG8_BAR; PG8_WAIT_L(0); PG8_MMA(0, 1, At, B1); PG8_BAR;
            PG8_LDA(At, 1, 1); PG8_STAGE(PG8_SA(1, 0), a3, voffA);
            PG8_BAR; PG8_WAIT_L(0); PG8_MMA(1, 0, At, B0); PG8_BAR; PG8_SCHED;
            PG8_STAGE(PG8_SB(1, 1), b3 + hstep, voffB);
            PG8_WAIT_V(6); PG8_BAR; PG8_MMA(1, 1, At, B1); PG8_BAR;
            }
        }
        if constexpr (ALIGN_EPI) { if (wr == 0) PG8_BAR; }
        if constexpr (!Epi::AFTER_DRAIN) { E(acc, cur, wr, wc, fr, fq); S.done(cur); }
        if (!has_next) break;
#pragma unroll
        for (int a = 0; a < 2; ++a)
#pragma unroll
            for (int b = 0; b < 2; ++b)
#pragma unroll
                for (int m = 0; m < 4; ++m)
#pragma unroll
                    for (int n = 0; n < 2; ++n) acc[a][b][m][n] = (f32x4){0.f, 0.f, 0.f, 0.f};
        cur = nxt; cA = nA; cB = nB; ++ui;
        if constexpr (ALIGN_EPI) { if (wr == 1) PG8_BAR; }
    }
    PG8_WAIT_V(0);
    if constexpr (!ALIGN_EPI) { if (wr == 0) PG8_BAR; }
    PG8_BAR;
    if constexpr (Epi::AFTER_DRAIN) { E.fused(acc, cur, wr, wc, fr, fq, lds, wid, lane); S.done(cur); }
#undef PG8_SA
#undef PG8_SB
#undef PG8_STAGE
#undef PG8_LDA
#undef PG8_LDB
#undef PG8_MMA
#undef PG8_WAIT_V
#undef PG8_WAIT_L
#undef PG8_BAR
#undef PG8_SCHED
}
}


#define LAS __attribute__((address_space(3)))
typedef unsigned short bf16;
typedef short bf16x8 __attribute__((ext_vector_type(8)));
typedef float f32x4 __attribute__((ext_vector_type(4)));
typedef float f32x2 __attribute__((ext_vector_type(2)));
typedef unsigned u32x4 __attribute__((ext_vector_type(4)));
typedef unsigned u32x2 __attribute__((ext_vector_type(2)));

constexpr int NB = 16, SEQ = 2048, NMETA = 16, TT = SEQ + NMETA, DM = 1024, DFF = 4096, NL = 4;
constexpr int MR = NB * SEQ;
constexpr int MT = MR + NMETA;
constexpr int INC = 3328;
constexpr int C_R = 0, C_K = 512, C_V = 1024, C_DW = 1536, C_DA = 1600, C_DG = 1664, C_Q = 1792, C_SK = 2304, C_SV = 2816;
constexpr int NWAVES = 8, NTHR = 512;
constexpr int LDS_BYTES = 147456;

constexpr size_t WS_CTL = 0;
constexpr size_t WS_BAR = 4096;
constexpr size_t WS_HM = 20480;
constexpr size_t WS_WIN = WS_HM + (size_t)NMETA * DM * 4;
constexpr size_t SZ_WIN = (size_t)INC * DM * 2;
constexpr size_t WS_WOUT = WS_WIN + NL * SZ_WIN;
constexpr size_t SZ_WOUT = (size_t)DM * DM * 2;
constexpr size_t WS_WUP = WS_WOUT + NL * SZ_WOUT;
constexpr size_t SZ_WUP = (size_t)DFF * DM * 2;
constexpr size_t WS_WDN = WS_WUP + NL * SZ_WUP;
constexpr size_t SZ_WDN = SZ_WUP;
constexpr size_t WS_WD = WS_WDN + NL * SZ_WDN;
constexpr size_t SZ_WD = (size_t)512 * 64 * 2;
constexpr size_t WS_WA = WS_WD + NL * SZ_WD;
constexpr size_t WS_WG = WS_WA + NL * SZ_WD;
constexpr size_t SZ_WG = (size_t)512 * 128 * 2;
constexpr size_t WS_RA = WS_WG + NL * SZ_WG;
constexpr size_t SZ_RA = (size_t)MT * DM * 2;
constexpr size_t WS_RB = WS_RA + SZ_RA;
constexpr size_t SZ_RB = (size_t)MT * DFF * 2;
constexpr size_t WS_T2HI = WS_RB + SZ_RB;
constexpr size_t WS_END = WS_T2HI + (size_t)MT * 512 * 4;

struct Params {
    const float* x; const float* meta; const float* g_pre_mix; const float* g_post_mix; const float* g_pre_ffn; const float* g_post_ffn;
    const float* w_in; const float* mu; const float* w_decay_up; const float* decay_bias; const float* w_a_up; const float* a_bias; const float* w_g_up;
    const float* k_k; const float* k_a; const float* r_k; const float* lnx_gain; const float* lnx_bias; const float* sb_gain;
    const float* w_out; const float* w_up; const float* w_dn;
    float* out; unsigned char* ws;
};

typedef const __attribute__((address_space(4))) Params* KParams;
__device__ __forceinline__ KParams kargs() { KParams k = (KParams)__builtin_amdgcn_kernarg_segment_ptr(); asm volatile("" : "+s"(k)); return k; }
__device__ __forceinline__ int ltid() { int t = threadIdx.x; asm volatile("" : "+v"(t)); return t; }
__device__ __forceinline__ unsigned f2bf(float f) { unsigned u = __builtin_bit_cast(unsigned, f); return (u + 0x7fffu + ((u >> 16) & 1u)) >> 16; }
__device__ __forceinline__ unsigned pk2(float lo, float hi) { unsigned r; asm volatile("v_cvt_pk_bf16_f32 %0, %1, %2" : "=v"(r) : "v"(lo), "v"(hi)); return r; }
__device__ __forceinline__ float bflo(unsigned u) { return __builtin_bit_cast(float, u << 16); }
__device__ __forceinline__ float bfhi(unsigned u) { return __builtin_bit_cast(float, u & 0xffff0000u); }
__device__ __forceinline__ int tokrow(int b, int t) { return t < NMETA ? MR + t : b * SEQ + (t - NMETA); }
__device__ __forceinline__ float wave_sum(float v) {
#pragma unroll
    for (int o = 1; o < 64; o <<= 1) v += __shfl_xor(v, o);
    return v;
}

template <int CTRL> __device__ __forceinline__ float dppf(float x) {
    return __builtin_bit_cast(float, __builtin_amdgcn_update_dpp(0, __builtin_bit_cast(int, x), CTRL, 0xF, 0xF, true));
}
__device__ __forceinline__ float sum8(float v) {
    v += dppf<0xB1>(v);
    v += dppf<0x4E>(v);
    v += dppf<0x141>(v);
    return v;
}
__device__ __forceinline__ float sum16(float v) {
    v += dppf<0xB1>(v);
    v += dppf<0x4E>(v);
    v += dppf<0x141>(v);
    v += dppf<0x140>(v);
    return v;
}
__device__ __forceinline__ float fast_exp(float x) { return __builtin_amdgcn_exp2f(x * 1.4426950408889634f); }
__device__ __forceinline__ float fast_log(float x) { return __builtin_amdgcn_logf(x) * 0.6931471805599453f; }
__device__ __forceinline__ float softplusf(float z) { return fmaxf(z, 0.f) + fast_log(1.f + fast_exp(-fabsf(z))); }
__device__ __forceinline__ float sigmoidf_(float z) { return __builtin_amdgcn_rcpf(1.f + fast_exp(-z)); }

template <class T> __device__ __forceinline__ T ldnt(const void* p) { return __builtin_nontemporal_load((const T*)p); }

struct EpiOut {
    static constexpr bool PERM = true, AFTER_DRAIN = false;
    bf16* O; int ldc; int act;
    __device__ __forceinline__ void operator()(const f32x4 (&acc)[2][2][4][2], const pg8::Unit& u, int wr, int wc, int fr, int fq) const {
        const int row0 = u.pm * 256 + wr * 64 + fr, col0 = u.pn * 256 + wc * 32 + 8 * fq;
#pragma unroll
        for (int ai = 0; ai < 2; ++ai)
#pragma unroll
            for (int m = 0; m < 4; ++m) { bf16* rowp = O + (size_t)(row0 + ai * 128 + m * 16) * ldc + col0;
#pragma unroll
                for (int bj = 0; bj < 2; ++bj) { f32x4 v0 = acc[ai][bj][m][0], v1 = acc[ai][bj][m][1];
                    if (act) {
#pragma unroll
                        for (int e = 0; e < 4; ++e) { float a = fmaxf(v0[e], 0.f), b = fmaxf(v1[e], 0.f); v0[e] = a * a; v1[e] = b * b; } }
                    u32x4 w; w.x = pk2(v0[0], v0[1]); w.y = pk2(v0[2], v0[3]); w.z = pk2(v1[0], v1[1]); w.w = pk2(v1[2], v1[3]);
                    *(u32x4*)(rowp + bj * 128) = w; } }
    }
};

struct EpiF32Split {
    static constexpr bool PERM = true, AFTER_DRAIN = false;
    float* lo; float* hi;
    __device__ __forceinline__ void operator()(const f32x4 (&acc)[2][2][4][2], const pg8::Unit& u, int wr, int wc, int fr, int fq) const {
        const int row0 = u.pm * 256 + wr * 64 + fr, col0 = (u.pn & 1) * 256 + wc * 32 + 8 * fq;
        float* base = (u.pn < 2) ? lo : hi;
#pragma unroll
        for (int ai = 0; ai < 2; ++ai)
#pragma unroll
            for (int m = 0; m < 4; ++m) { float* rowp = base + (size_t)(row0 + ai * 128 + m * 16) * 512 + col0;
#pragma unroll
                for (int bj = 0; bj < 2; ++bj) { *(f32x4*)(rowp + bj * 128) = acc[ai][bj][m][0]; *(f32x4*)(rowp + bj * 128 + 4) = acc[ai][bj][m][1]; } }
    }
};

__device__ __forceinline__ void meta_gemm(const bf16* A, const bf16* Bt, int N, int K, bf16* O, int act, int gw, int ngw, int lane, float* flo = nullptr, float* fhi = nullptr) {
    const int i = lane & 15, g = lane >> 4;
    for (int task = gw; task < N / 16; task += ngw) {
        const int n0 = task * 16;
        const bf16* ap = Bt + (size_t)(n0 + i) * K + 8 * g;
        const bf16* bp = A + (size_t)(MR + i) * K + 8 * g;
        f32x4 acc = {0.f, 0.f, 0.f, 0.f};
#pragma unroll 4
        for (int k0 = 0; k0 < K; k0 += 32) {
            bf16x8 a = ldnt<bf16x8>(ap + k0), b = ldnt<bf16x8>(bp + k0);
            acc = __builtin_amdgcn_mfma_f32_16x16x32_bf16(a, b, acc, 0, 0, 0);
        }
        if (act) {
#pragma unroll
            for (int e = 0; e < 4; ++e) { float a = fmaxf(acc[e], 0.f); acc[e] = a * a; } }
        if (flo) { float* base = (n0 < 512) ? flo : fhi; *(f32x4*)(base + (size_t)(MR + i) * 512 + (n0 & 511) + 4 * g) = acc; }
        else { u32x2 w; w.x = pk2(acc[0], acc[1]); w.y = pk2(acc[2], acc[3]);
        *(u32x2*)(O + (size_t)(MR + i) * N + n0 + 4 * g) = w; }
    }
}

__device__ __forceinline__ void transpose_item(const float* W, int K, int N, bf16* WT, LAS float* scr, int item, int lane) {
    const int nblk = N / 32, kb = item / nblk, nb = item % nblk, k0 = 64 * kb, n0 = 32 * nb;
#pragma unroll 8
    for (int i = 0; i < 32; ++i) { const int kk = 2 * i + (lane >> 5); scr[kk * 33 + (lane & 31)] = W[(size_t)(k0 + kk) * N + n0 + (lane & 31)]; }
    asm volatile("s_waitcnt lgkmcnt(0)" ::: "memory");
    const int c = lane & 7;
#pragma unroll
    for (int j = 0; j < 4; ++j) { const int n = (lane >> 3) + 8 * j; const LAS float* s = scr + (8 * c) * 33 + n;
        u32x4 o; o.x = pk2(s[0 * 33], s[1 * 33]); o.y = pk2(s[2 * 33], s[3 * 33]); o.z = pk2(s[4 * 33], s[5 * 33]); o.w = pk2(s[6 * 33], s[7 * 33]);
        *(u32x4*)(WT + (size_t)(n0 + n) * K + k0 + 8 * c) = o; }
    asm volatile("s_waitcnt lgkmcnt(0)" ::: "memory");
}
__device__ __forceinline__ void conv_phase(const Params& p, LAS unsigned char* lds, int it_lo_layers, int it_hi_layers, int wg, int nwg) {
    const int t_ = ltid(), lane = t_ & 63, wave = t_ >> 6, gw = wg * NWAVES + wave, ngw = nwg * NWAVES;
    LAS float* scr = (LAS float*)(lds + wave * 16384);
    constexpr int I_IN = 16 * 104, I_OUT = 16 * 32, I_UP = 16 * 128, I_DN = 64 * 32, I_D = 16, I_A = 16, I_G = 32;
    constexpr int PER = I_IN + I_OUT + I_UP + I_DN + I_D + I_A + I_G;
    for (int it = it_lo_layers * PER + gw; it < it_hi_layers * PER; it += ngw) {
        const int l = it / PER; int r = it % PER;
        if (r < I_IN) { transpose_item(p.w_in + (size_t)l * DM * INC, DM, INC, (bf16*)(p.ws + WS_WIN + l * SZ_WIN), scr, r, lane); continue; } r -= I_IN;
        if (r < I_OUT) { transpose_item(p.w_out + (size_t)l * DM * DM, DM, DM, (bf16*)(p.ws + WS_WOUT + l * SZ_WOUT), scr, r, lane); continue; } r -= I_OUT;
        if (r < I_UP) { transpose_item(p.w_up + (size_t)l * DM * DFF, DM, DFF, (bf16*)(p.ws + WS_WUP + l * SZ_WUP), scr, r, lane); continue; } r -= I_UP;
        if (r < I_DN) { transpose_item(p.w_dn + (size_t)l * DFF * DM, DFF, DM, (bf16*)(p.ws + WS_WDN + l * SZ_WDN), scr, r, lane); continue; } r -= I_DN;
        if (r < I_D) { transpose_item(p.w_decay_up + (size_t)l * 64 * 512, 64, 512, (bf16*)(p.ws + WS_WD + l * SZ_WD), scr, r, lane); continue; } r -= I_D;
        if (r < I_A) { transpose_item(p.w_a_up + (size_t)l * 64 * 512, 64, 512, (bf16*)(p.ws + WS_WA + l * SZ_WD), scr, r, lane); continue; } r -= I_A;
        transpose_item(p.w_g_up + (size_t)l * 128 * 512, 128, 512, (bf16*)(p.ws + WS_WG + l * SZ_WG), scr, r, lane);
    }
}

__device__ __forceinline__ void norm_phase(const float* T, const float* Thi, const float* g1, const float* hin_real, const float* hin_meta, float* hout_real, float* hout_meta,
                                           const float* g2, bf16* xn) {
    const int t_ = ltid(), lane = t_ & 63, gw = blockIdx.x * NWAVES + (t_ >> 6), ngw = gridDim.x * NWAVES;
    for (int m = gw; m < MT; m += ngw) {
        const float* hi = m < MR ? hin_real + (size_t)m * DM : hin_meta + (size_t)(m - MR) * DM;
        float* ho = m < MR ? hout_real + (size_t)m * DM : hout_meta + (size_t)(m - MR) * DM;
        f32x4 h[4];
#pragma unroll
        for (int j = 0; j < 4; ++j) h[j] = *((const f32x4*)hi + lane + 64 * j);
        if (T) {
            f32x4 t[4]; float ss = 0.f;
#pragma unroll
            for (int j = 0; j < 4; ++j) { t[j] = *((const f32x4*)((j < 2 ? T : Thi) + (size_t)m * 512) + lane + 64 * (j & 1));
                ss += (t[j].x * t[j].x + t[j].y * t[j].y) + (t[j].z * t[j].z + t[j].w * t[j].w); }
            const float r1 = 1.f / sqrtf(wave_sum(ss) * (1.f / DM) + 1e-6f);
#pragma unroll
            for (int j = 0; j < 4; ++j) { f32x4 gg = *((const f32x4*)g1 + lane + 64 * j); h[j] = h[j] + t[j] * r1 * gg; *((f32x4*)ho + lane + 64 * j) = h[j]; }
        }
        if (g2) {
            float ss = 0.f;
#pragma unroll
            for (int j = 0; j < 4; ++j) ss += (h[j].x * h[j].x + h[j].y * h[j].y) + (h[j].z * h[j].z + h[j].w * h[j].w);
            const float r2 = 1.f / sqrtf(wave_sum(ss) * (1.f / DM) + 1e-6f);
            u32x2* o = (u32x2*)(xn + (size_t)m * DM) + lane;
#pragma unroll
            for (int j = 0; j < 4; ++j) { f32x4 gg = *((const f32x4*)g2 + lane + 64 * j); f32x4 v = h[j] * r2 * gg;
                u32x2 w; w.x = pk2(v.x, v.y); w.y = pk2(v.z, v.w); o[64 * j] = w; }
        }
    }
}

constexpr int RW_CH = 32;
constexpr int RW_R = 0, RW_W = 8192, RW_K = 16384, RW_V = 24576, RW_KKN = 32768, RW_B = 40960, RW_Y = 49152, RW_G = 57344;
constexpr int RW_TD = 65536, RW_DA = 70144, RW_SG = 74752, RW_BON = 83456;

__device__ __forceinline__ void rwkv_chain(const Params& p, int l, int b, int h, LAS unsigned char* lds, int tid) {
    const int wave = tid >> 6, lane = tid & 63;
    const bf16* P = (const bf16*)(p.ws + WS_RB);
    bf16* Yo = (bf16*)(p.ws + WS_RA);
    LAS float* R = (LAS float*)(lds + RW_R); LAS float* W = (LAS float*)(lds + RW_W); LAS float* Kx = (LAS float*)(lds + RW_K); LAS float* V = (LAS float*)(lds + RW_V);
    LAS float* KKN = (LAS float*)(lds + RW_KKN); LAS float* BV = (LAS float*)(lds + RW_B); LAS float* Y = (LAS float*)(lds + RW_Y); LAS float* G = (LAS float*)(lds + RW_G);
    LAS bf16* TD = (LAS bf16*)(lds + RW_TD); LAS bf16* DA = (LAS bf16*)(lds + RW_DA); LAS bf16* SG = (LAS bf16*)(lds + RW_SG); LAS float* BON = (LAS float*)(lds + RW_BON);
    const float* mu = p.mu + (size_t)l * 1792;
    const int mt = wave & 1, nt = wave >> 1, fi = lane & 15, fg = lane >> 4;
    bf16x8 wdF[2], waF[2], wgF[4];
    {
        const bf16* wd = (const bf16*)(p.ws + WS_WD + l * SZ_WD) + (size_t)(h * 64 + nt * 16 + fi) * 64 + 8 * fg;
        const bf16* wa = (const bf16*)(p.ws + WS_WA + l * SZ_WD) + (size_t)(h * 64 + nt * 16 + fi) * 64 + 8 * fg;
        const bf16* wg = (const bf16*)(p.ws + WS_WG + l * SZ_WG) + (size_t)(h * 64 + nt * 16 + fi) * 128 + 8 * fg;
        wdF[0] = *(const bf16x8*)wd; wdF[1] = *(const bf16x8*)(wd + 32);
        waF[0] = *(const bf16x8*)wa; waF[1] = *(const bf16x8*)(wa + 32);
#pragma unroll
        for (int k = 0; k < 4; ++k) wgF[k] = *(const bf16x8*)(wg + 32 * k);
    }
    const int cB = h * 64 + nt * 16 + fi;
    const float dbias = p.decay_bias[l * 512 + cB], abias = p.a_bias[l * 512 + cB];
    const int tokC = tid >> 4, ch4 = (tid & 15) * 4, cC = h * 64 + ch4;
    const f32x4 kkv = *(const f32x4*)(p.k_k + l * 512 + cC), kav = *(const f32x4*)(p.k_a + l * 512 + cC), rkv = *(const f32x4*)(p.r_k + l * 512 + cC);
    const f32x4 lgv = *(const f32x4*)(p.lnx_gain + l * 512 + cC), lbv = *(const f32x4*)(p.lnx_bias + l * 512 + cC);
    const int vrow = (tid >> 3) & 31, kq = tid & 7;
    f32x2 S[2][4];
#pragma unroll
    for (int q = 0; q < 2; ++q)
#pragma unroll
        for (int j = 0; j < 4; ++j) S[q][j] = (f32x2){0.f, 0.f};

    u32x4 pc[4], pp[4];
    LAS float* MU = (LAS float*)(lds + 83968);
    if (tid < 448) { const int gi = tid >> 3; const int col = gi < 24 ? (gi >> 3) * 512 + h * 64 + (gi & 7) * 8 : C_DW + (gi - 24) * 8; MU[tid] = mu[col + (tid & 7)]; }
#pragma unroll
    for (int k = 0; k < 4; ++k) { pc[k] = (u32x4){0u, 0u, 0u, 0u}; pp[k] = pc[k]; }
#define RW_IK(k) (((tid + NTHR * (k)) * 4682) >> 18)
#define RW_GIK(k) ((tid + NTHR * (k)) - 56 * RW_IK(k))
#define RW_COL(gi) ((gi) < 24 ? ((gi) >> 3) * 512 + h * 64 + ((gi) & 7) * 8 : C_DW + ((gi) - 24) * 8)
#define RW_ISSUE(T0, NT) do { _Pragma("unroll") for (int k = 0; k < 4; ++k) { if (tid + NTHR * k < (NT) * 56) { const int t_ = (T0) + RW_IK(k); const int c_ = RW_COL(RW_GIK(k)); \
        pc[k] = ldnt<u32x4>(P + (size_t)tokrow(b, t_) * INC + c_); pp[k] = (u32x4){0u, 0u, 0u, 0u}; \
        if (t_ > 0) pp[k] = ldnt<u32x4>(P + (size_t)tokrow(b, t_ - 1) * INC + c_); } } } while (0)
    RW_ISSUE(0, NMETA);
    __syncthreads();
    for (int t0 = 0; t0 < TT; ) {
        const int ntok = (t0 == 0) ? NMETA : RW_CH;
#pragma unroll
        for (int k = 0; k < 4; ++k) {
            if (tid + NTHR * k < ntok * 56) {
                const int i = RW_IK(k), gi = RW_GIK(k);
                float xv[8];
                {
                    const unsigned cu[4] = {pc[k].x, pc[k].y, pc[k].z, pc[k].w}, pu[4] = {pp[k].x, pp[k].y, pp[k].z, pp[k].w};
                    const f32x4 ma = *(const LAS f32x4*)(MU + gi * 8), mb = *(const LAS f32x4*)(MU + gi * 8 + 4);
                    const float mm[8] = {ma.x, ma.y, ma.z, ma.w, mb.x, mb.y, mb.z, mb.w};
#pragma unroll
                    for (int e = 0; e < 4; ++e) { float c0 = bflo(cu[e]), c1 = bfhi(cu[e]), q0 = bflo(pu[e]), q1 = bfhi(pu[e]);
                        xv[2 * e] = c0 + (q0 - c0) * mm[2 * e]; xv[2 * e + 1] = c1 + (q1 - c1) * mm[2 * e + 1]; }
                }
                if (gi < 24) {
                    LAS float* dst = (gi < 8 ? R : (gi < 16 ? Kx : V)) + i * 64 + (gi & 7) * 8;
                    *(LAS f32x4*)dst = (f32x4){xv[0], xv[1], xv[2], xv[3]}; *(LAS f32x4*)(dst + 4) = (f32x4){xv[4], xv[5], xv[6], xv[7]};
                } else if (gi >= 32 && gi < 40) {
                    u32x4 w; w.x = pk2(xv[0], xv[1]); w.y = pk2(xv[2], xv[3]); w.z = pk2(xv[4], xv[5]); w.w = pk2(xv[6], xv[7]);
                    *(LAS u32x4*)(DA + i * 72 + (gi - 32) * 8) = w;
                } else {
                    const bool th = gi < 32; const float sc = th ? 2.f : 1.f, ka = th ? 2.f : 1.f, kb = th ? -1.f : 0.f;
                    float tv[8];
#pragma unroll
                    for (int e = 0; e < 8; ++e) tv[e] = ka * sigmoidf_(sc * xv[e]) + kb;
                    u32x4 w; w.x = pk2(tv[0], tv[1]); w.y = pk2(tv[2], tv[3]); w.z = pk2(tv[4], tv[5]); w.w = pk2(tv[6], tv[7]);
                    LAS bf16* dstb = th ? TD + i * 72 + (gi - 24) * 8 : SG + i * 136 + (gi - 40) * 8;
                    *(LAS u32x4*)dstb = w;
                }
            }
        }
        __syncthreads();
#ifndef ISSUE_LATE
        if (t0 + ntok < TT) RW_ISSUE(t0 + ntok, RW_CH);
#endif
        {
            f32x4 ad = {0.f, 0.f, 0.f, 0.f}, aa = ad, ag = ad;
#pragma unroll
            for (int ks = 0; ks < 2; ++ks) {
                bf16x8 fa = *(const LAS bf16x8*)(TD + (16 * mt + fi) * 72 + 32 * ks + 8 * fg);
                ad = __builtin_amdgcn_mfma_f32_16x16x32_bf16(fa, wdF[ks], ad, 0, 0, 0);
                bf16x8 fb = *(const LAS bf16x8*)(DA + (16 * mt + fi) * 72 + 32 * ks + 8 * fg);
                aa = __builtin_amdgcn_mfma_f32_16x16x32_bf16(fb, waF[ks], aa, 0, 0, 0);
            }
#pragma unroll
            for (int ks = 0; ks < 4; ++ks) {
                bf16x8 fc = *(const LAS bf16x8*)(SG + (16 * mt + fi) * 136 + 32 * ks + 8 * fg);
                ag = __builtin_amdgcn_mfma_f32_16x16x32_bf16(fc, wgF[ks], ag, 0, 0, 0);
            }
#pragma unroll
            for (int r = 0; r < 4; ++r) {
                const int tok = 16 * mt + 4 * fg + r, o = tok * 64 + nt * 16 + fi;
                const float xd = dbias + ad[r];
                const float wlog = -softplusf(-xd) - 0.5f;
                W[o] = fast_exp(-fast_exp(wlog));
                BV[o] = sigmoidf_(abias + aa[r]);
                G[o] = ag[r];
            }
        }
        __syncthreads();
        {
            const int o = tokC * 64 + ch4;
            const f32x4 k = *(const LAS f32x4*)(Kx + o), a = *(const LAS f32x4*)(BV + o), r = *(const LAS f32x4*)(R + o);
            f32x4 kk = k * kkv;
            const float ss = sum16((kk.x * kk.x + kk.y * kk.y) + (kk.z * kk.z + kk.w * kk.w));
            const float inv = 1.f / sqrtf(ss + 1e-12f);
            kk = kk * inv;
            const f32x4 km = k * (1.f + (a - 1.f) * kav);
            const f32x4 bb = r * km * rkv;
            const float bon = sum16((bb.x + bb.y) + (bb.z + bb.w));
            *(LAS f32x4*)(KKN + o) = -kk; *(LAS f32x4*)(BV + o) = kk * a; *(LAS f32x4*)(Kx + o) = km;
            if ((tid & 15) == 0) BON[tokC] = bon;
        }
        __syncthreads();
#ifdef ISSUE_LATE
        if (t0 + ntok < TT) RW_ISSUE(t0 + ntok, RW_CH);
#endif
        if (tid < 256) {
#ifndef SCAN_UNROLL
#define SCAN_UNROLL 2
#endif
#pragma unroll SCAN_UNROLL
            for (int i = 0; i < ntok; ++i) {
                const int o = i * 64 + kq * 8;
                const f32x4 n0 = *(const LAS f32x4*)(KKN + o), n1 = *(const LAS f32x4*)(KKN + o + 4);
                const f32x4 w0 = *(const LAS f32x4*)(W + o), w1 = *(const LAS f32x4*)(W + o + 4);
                const f32x4 b0 = *(const LAS f32x4*)(BV + o), b1 = *(const LAS f32x4*)(BV + o + 4);
                const f32x4 k0 = *(const LAS f32x4*)(Kx + o), k1 = *(const LAS f32x4*)(Kx + o + 4);
                const f32x4 r0 = *(const LAS f32x4*)(R + o), r1 = *(const LAS f32x4*)(R + o + 4);
                const f32x2 vpair = *(const LAS f32x2*)(V + i * 64 + 2 * vrow);
                const f32x2 nn[4] = {{n0.x, n0.y}, {n0.z, n0.w}, {n1.x, n1.y}, {n1.z, n1.w}};
                const f32x2 ww[4] = {{w0.x, w0.y}, {w0.z, w0.w}, {w1.x, w1.y}, {w1.z, w1.w}};
                const f32x2 bb[4] = {{b0.x, b0.y}, {b0.z, b0.w}, {b1.x, b1.y}, {b1.z, b1.w}};
                const f32x2 kk2[4] = {{k0.x, k0.y}, {k0.z, k0.w}, {k1.x, k1.y}, {k1.z, k1.w}};
                const f32x2 rr2[4] = {{r0.x, r0.y}, {r0.z, r0.w}, {r1.x, r1.y}, {r1.z, r1.w}};
                float sa[2], yy[2];
#pragma unroll
                for (int q = 0; q < 2; ++q) {
                    f32x2 s2 = S[q][0] * nn[0];
                    s2 = __builtin_elementwise_fma(S[q][1], nn[1], s2);
                    f32x2 s3 = S[q][2] * nn[2];
                    s3 = __builtin_elementwise_fma(S[q][3], nn[3], s3);
                    s2 = s2 + s3;
                    sa[q] = s2.x + s2.y;
                }
                sa[0] += dppf<0xB1>(sa[0]); sa[1] += dppf<0xB1>(sa[1]);
                sa[0] += dppf<0x4E>(sa[0]); sa[1] += dppf<0x4E>(sa[1]);
                sa[0] += dppf<0x141>(sa[0]); sa[1] += dppf<0x141>(sa[1]);
#pragma unroll
                for (int q = 0; q < 2; ++q) {
                    const f32x2 sa2 = {sa[q], sa[q]}, vv2 = {vpair[q], vpair[q]};
#pragma unroll
                    for (int j = 0; j < 4; ++j) S[q][j] = __builtin_elementwise_fma(S[q][j], ww[j], __builtin_elementwise_fma(sa2, bb[j], vv2 * kk2[j]));
                    f32x2 y2 = S[q][0] * rr2[0];
                    y2 = __builtin_elementwise_fma(S[q][1], rr2[1], y2);
                    f32x2 y3 = S[q][2] * rr2[2];
                    y3 = __builtin_elementwise_fma(S[q][3], rr2[3], y3);
                    y2 = y2 + y3;
                    yy[q] = y2.x + y2.y;
                }
                yy[0] += dppf<0xB1>(yy[0]); yy[1] += dppf<0xB1>(yy[1]);
                yy[0] += dppf<0x4E>(yy[0]); yy[1] += dppf<0x4E>(yy[1]);
                yy[0] += dppf<0x141>(yy[0]); yy[1] += dppf<0x141>(yy[1]);
                if (kq == 0) *(LAS f32x2*)(Y + i * 64 + 2 * vrow) = (f32x2){yy[0], yy[1]};
            }
        }
        __syncthreads();
        if (tokC < ntok && (t0 > 0 || b == 0)) {
            const int o = tokC * 64 + ch4;
            const f32x4 y = *(const LAS f32x4*)(Y + o);
            const float mean = sum16((y.x + y.y) + (y.z + y.w)) * (1.f / 64.f);
            const f32x4 d = y - mean;
            const float var = sum16((d.x * d.x + d.y * d.y) + (d.z * d.z + d.w * d.w)) * (1.f / 64.f);
            const float rs = 1.f / sqrtf(var + 6.4e-4f);
            f32x4 yn = d * rs * lgv + lbv;
            const f32x4 vv = *(const LAS f32x4*)(V + o), gg = *(const LAS f32x4*)(G + o);
            yn = (yn + BON[tokC] * vv) * gg;
            u32x2 w; w.x = pk2(yn.x, yn.y); w.y = pk2(yn.z, yn.w);
            *(u32x2*)(Yo + (size_t)tokrow(b, t0 + tokC) * DM + cC) = w;
        } else if (tokC < ntok) {
        }
        __syncthreads();
        t0 += ntok;
    }
}

constexpr int SB_KS = 0, SB_VT = 9216, SB_Q = 18432;
#ifndef SB_THR_VAL
#define SB_THR_VAL 90.f
#endif
constexpr float SB_THR = SB_THR_VAL;

__device__ __forceinline__ void sb_unit(const Params& p, int l, int b, int h, int qb, LAS unsigned char* lds, int tid) {
    const int wave = tid >> 6, lane = tid & 63, ql = lane & 15, g = lane >> 4;
    const bf16* P = (const bf16*)(p.ws + WS_RB);
    bf16* Yo = (bf16*)(p.ws + WS_RA);
    LAS bf16* Ks = (LAS bf16*)(lds + SB_KS); LAS bf16* Vt = (LAS bf16*)(lds + SB_VT);
    const int tq = (qb < 0 ? 0 : NMETA + 128 * qb) + 16 * wave + ql;
    const bool wave_valid = (qb >= 0) || (wave == 0);
    const int tqc = wave_valid ? tq : 0;
    bf16x8 qF[2];
    {
        const bf16* qp = P + (size_t)tokrow(b, tqc) * INC + C_Q + h * 64 + 8 * g;
        qF[0] = ldnt<bf16x8>(qp); qF[1] = ldnt<bf16x8>(qp + 32);
    }
    unsigned P01, P23; const unsigned ONES = 0x3F803F80u;
    { const unsigned p0 = (4 * g + 0 > ql) ? 0x3F80u : 0u, p1 = (4 * g + 1 > ql) ? 0x3F80u : 0u, p2 = (4 * g + 2 > ql) ? 0x3F80u : 0u, p3 = (4 * g + 3 > ql) ? 0x3F80u : 0u;
      P01 = p0 | (p1 << 16); P23 = p2 | (p3 << 16); }
    const bf16x8 FA = __builtin_bit_cast(bf16x8, (u32x4){P01, P23, ONES, ONES});
    const bf16x8 FB = __builtin_bit_cast(bf16x8, (u32x4){0u, 0u, P01, P23});
    const bf16x8 F1 = __builtin_bit_cast(bf16x8, (u32x4){ONES, ONES, ONES, ONES});
    f32x4 O[4];
#pragma unroll
    for (int d = 0; d < 4; ++d) O[d] = (f32x4){0.f, 0.f, 0.f, 0.f};
    float carry = 0.f;
    const int wave_tq_max = (qb < 0 ? 0 : NMETA + 128 * qb) + 16 * wave + 15;
    const int i_hi = qb < 0 ? 0 : 2 * qb + 2;
    const int kap = tid >> 3, piece = tid & 7;
    const int slot = (kap >> 5) * 32 + ((kap >> 2) & 3) * 8 + ((kap >> 4) & 1) * 4 + (kap & 3);
    bool wave_done = !wave_valid;
    volatile LAS unsigned* orw = (volatile LAS unsigned*)(lds + SB_Q + 16);
    if (tid < 2) orw[tid] = 0u;
    int nit = 0;
    for (int it = i_hi; it >= 0; --it, ++nit) {
        const int tk0 = NMETA + 64 * (it - 1);
        {
            const int tk = tk0 + kap;
            u32x4 kv = {0u, 0u, 0u, 0u}, vv = kv;
            if (tk >= 0) { const bf16* rp = P + (size_t)tokrow(b, tk) * INC + h * 64 + piece * 8; kv = ldnt<u32x4>(rp + C_SK); vv = ldnt<u32x4>(rp + C_SV); }
            *(LAS u32x4*)(Ks + kap * 72 + piece * 8) = kv;
            const unsigned vu[4] = {vv.x, vv.y, vv.z, vv.w};
#pragma unroll
            for (int e = 0; e < 4; ++e) { Vt[(piece * 8 + 2 * e) * 72 + slot] = (bf16)(vu[e] & 0xffffu); Vt[(piece * 8 + 2 * e + 1) * 72 + slot] = (bf16)(vu[e] >> 16); }
        }
        __syncthreads();
        if (!wave_done && tk0 < wave_tq_max) {
            f32x4 s[4];
#pragma unroll
            for (int m = 0; m < 4; ++m) {
                s[m] = (f32x4){0.f, 0.f, 0.f, 0.f};
#pragma unroll
                for (int ks = 0; ks < 2; ++ks) {
                    bf16x8 a = *(const LAS bf16x8*)(Ks + (16 * m + ql) * 72 + 32 * ks + 8 * g);
                    s[m] = __builtin_amdgcn_mfma_f32_16x16x32_bf16(a, qF[ks], s[m], 0, 0, 0);
                }
            }
            float z[4][4], sp[4][4]; bool val[4][4];
            unsigned hi[4][2], lo[4][2];
#pragma unroll
            for (int m = 0; m < 4; ++m) {
#pragma unroll
                for (int r = 0; r < 4; ++r) {
                    const int tk = tk0 + 16 * m + 4 * g + r;
                    val[m][r] = (tk >= 0) && (tk < tq);
                    z[m][r] = s[m][r] * 0.125f;
                    sp[m][r] = val[m][r] ? softplusf(z[m][r]) : 0.f;
                }
#pragma unroll
                for (int r2 = 0; r2 < 2; ++r2) {
                    const unsigned hh = pk2(sp[m][2 * r2], sp[m][2 * r2 + 1]);
                    hi[m][r2] = hh;
                    lo[m][r2] = pk2(sp[m][2 * r2] - bflo(hh), sp[m][2 * r2 + 1] - bfhi(hh));
                }
            }
            const bf16x8 hF0 = __builtin_bit_cast(bf16x8, (u32x4){hi[0][0], hi[0][1], hi[1][0], hi[1][1]});
            const bf16x8 hF1 = __builtin_bit_cast(bf16x8, (u32x4){hi[2][0], hi[2][1], hi[3][0], hi[3][1]});
            const bf16x8 lF0 = __builtin_bit_cast(bf16x8, (u32x4){lo[0][0], lo[0][1], lo[1][0], lo[1][1]});
            const bf16x8 lF1 = __builtin_bit_cast(bf16x8, (u32x4){lo[2][0], lo[2][1], lo[3][0], lo[3][1]});
            f32x4 cum[4];
            const f32x4 zero4 = {0.f, 0.f, 0.f, 0.f};
            cum[0] = __builtin_amdgcn_mfma_f32_16x16x32_bf16(FA, hF0, zero4, 0, 0, 0);
            cum[0] = __builtin_amdgcn_mfma_f32_16x16x32_bf16(FA, lF0, cum[0], 0, 0, 0);
            cum[0] = __builtin_amdgcn_mfma_f32_16x16x32_bf16(F1, hF1, cum[0], 0, 0, 0);
            cum[0] = __builtin_amdgcn_mfma_f32_16x16x32_bf16(F1, lF1, cum[0], 0, 0, 0);
            cum[1] = __builtin_amdgcn_mfma_f32_16x16x32_bf16(FB, hF0, zero4, 0, 0, 0);
            cum[1] = __builtin_amdgcn_mfma_f32_16x16x32_bf16(FB, lF0, cum[1], 0, 0, 0);
            cum[1] = __builtin_amdgcn_mfma_f32_16x16x32_bf16(F1, hF1, cum[1], 0, 0, 0);
            cum[1] = __builtin_amdgcn_mfma_f32_16x16x32_bf16(F1, lF1, cum[1], 0, 0, 0);
            cum[2] = __builtin_amdgcn_mfma_f32_16x16x32_bf16(FA, hF1, zero4, 0, 0, 0);
            cum[2] = __builtin_amdgcn_mfma_f32_16x16x32_bf16(FA, lF1, cum[2], 0, 0, 0);
            cum[3] = __builtin_amdgcn_mfma_f32_16x16x32_bf16(FB, hF1, zero4, 0, 0, 0);
            cum[3] = __builtin_amdgcn_mfma_f32_16x16x32_bf16(FB, lF1, cum[3], 0, 0, 0);
            unsigned af[4][2];
#pragma unroll
            for (int m = 0; m < 4; ++m) {
                float av[4];
#pragma unroll
                for (int r = 0; r < 4; ++r) { const float la = (z[m][r] - sp[m][r]) - cum[m][r] - carry; av[r] = val[m][r] ? fast_exp(la) : 0.f; }
                af[m][0] = pk2(av[0], av[1]); af[m][1] = pk2(av[2], av[3]);
            }
            const bf16x8 aF0 = __builtin_bit_cast(bf16x8, (u32x4){af[0][0], af[0][1], af[1][0], af[1][1]});
            const bf16x8 aF1 = __builtin_bit_cast(bf16x8, (u32x4){af[2][0], af[2][1], af[3][0], af[3][1]});
            const float tot = __shfl(cum[0][0] + sp[0][0], ql);
            carry += tot;
#pragma unroll
            for (int d = 0; d < 4; ++d) {
                bf16x8 v0 = *(const LAS bf16x8*)(Vt + (16 * d + ql) * 72 + 8 * g);
                bf16x8 v1 = *(const LAS bf16x8*)(Vt + (16 * d + ql) * 72 + 32 + 8 * g);
                O[d] = __builtin_amdgcn_mfma_f32_16x16x32_bf16(v0, aF0, O[d], 0, 0, 0);
                O[d] = __builtin_amdgcn_mfma_f32_16x16x32_bf16(v1, aF1, O[d], 0, 0, 0);
            }
            if (__all(carry > SB_THR)) wave_done = true;
        }
        if (lane == 0 && !wave_done && it > 0) orw[nit & 1] = 1u;
        __syncthreads();
        const unsigned more = orw[nit & 1];
        if (tid == 0) orw[(nit + 1) & 1] = 0u;
        if (!more) break;
    }
    if (wave_valid && (qb >= 0 || b == 0)) {
        float ss = 0.f;
#pragma unroll
        for (int d = 0; d < 4; ++d) ss += (O[d].x * O[d].x + O[d].y * O[d].y) + (O[d].z * O[d].z + O[d].w * O[d].w);
        ss += __shfl_xor(ss, 16); ss += __shfl_xor(ss, 32);
        const float inv = 1.f / sqrtf(ss * (1.f / 64.f) + 1e-6f);
        bf16* yp = Yo + (size_t)tokrow(b, tq) * DM + 512 + h * 64;
        const float* gp = p.sb_gain + l * 512 + h * 64;
#pragma unroll
        for (int d = 0; d < 4; ++d) {
            const f32x4 gg = *(const f32x4*)(gp + 16 * d + 4 * g);
            const f32x4 v = O[d] * inv * gg;
            u32x2 w; w.x = pk2(v.x, v.y); w.y = pk2(v.z, v.w);
            *(u32x2*)(yp + 16 * d + 4 * g) = w;
        }
    }
}

__device__ __forceinline__ void mix_phase(const Params& p_in, int l, LAS unsigned char* lds, int cslot = -1) {
#if defined(__HIP_DEVICE_COMPILE__)
    const Params p = *kargs();
#else
    const Params& p = p_in;
#endif
    const int tid = ltid();
    const int G = gridDim.x;
#ifdef CHAINS_HIGH
    for (int c = (int)blockIdx.x - (G - NB * 8); c < NB * 8; c += G) if (c >= 0) rwkv_chain(
#else
    for (int c = blockIdx.x; c < NB * 8; c += G) rwkv_chain(
#endif
    p, l, c >> 3, c & 7, lds, tid);
    unsigned* ctr = (unsigned*)(p.ws + WS_CTL) + 64 * (cslot < 0 ? l + 1 : cslot);
    volatile LAS unsigned* qw = (volatile LAS unsigned*)(lds + SB_Q);
    for (;;) {
        __syncthreads();
        if (tid == 0) qw[0] = atomicAdd(ctr, 1u);
        __syncthreads();
        const unsigned u = qw[0];
        if (u >= 2048u + 8u) break;
        if (u < 2048u) { const int qb = 15 - (int)(u >> 7), bh = (int)(u & 127u); sb_unit(p, l, bh >> 3, bh & 7, qb, lds, tid); }
        else sb_unit(p, l, 0, (int)(u - 2048u), -1, lds, tid);
    }
    if (l == 0 && (int)blockIdx.x >= NB * 8) {
        __syncthreads();
        conv_phase(p, lds, 1, NL, (int)blockIdx.x - NB * 8, G - NB * 8);
    }
}


#ifdef DIAG_W
__device__ __forceinline__ bool check_win(const Params& p) {
    const int t = ltid(), xl = blockIdx.x >> 3, nxl = gridDim.x >> 3;
    bool bad = false;
    for (int l = 0; l < NL; ++l) {
        const float* W = p.w_in + (size_t)l * DM * INC; const bf16* WT = (const bf16*)(p.ws + WS_WIN + l * SZ_WIN);
        for (int g = xl * NTHR + t; g < INC * (DM / 8); g += nxl * NTHR) {
            const int n = g / (DM / 8), k0 = (g % (DM / 8)) * 8;
            const u32x4 v = *(const u32x4*)(WT + (size_t)n * DM + k0);
            const unsigned vv[4] = {v.x, v.y, v.z, v.w};
#pragma unroll
            for (int j = 0; j < 4; ++j) { const unsigned e = pk2(W[(size_t)(k0 + 2 * j) * INC + n], W[(size_t)(k0 + 2 * j + 1) * INC + n]); bad |= (e != vv[j]); }
        }
    }
    return __any(bad);
}
#endif

#define XB_TMO      128
#define XB_XCNT(j)  (256  + 64 * (j))
#define XB_XSUB(j)  (1280 + 64 * (j))
#define XB_XGEN(j)  (2304 + 64 * (j))
#define XB_TOP      3328
#define XB_TOPGEN   3392
#define XCD_BAR_WORDS 3456
#define XB_SPIN_CAP (1u << 18)

__device__ __forceinline__ unsigned xb_ld(unsigned* p)              { return __hip_atomic_load(p, __ATOMIC_RELAXED, __HIP_MEMORY_SCOPE_AGENT); }
__device__ __forceinline__ unsigned xb_add(unsigned* p, unsigned v) { return __hip_atomic_fetch_add(p, v, __ATOMIC_RELAXED, __HIP_MEMORY_SCOPE_AGENT); }
__device__ __forceinline__ unsigned xb_xcc_id() { return (unsigned)__builtin_amdgcn_s_getreg((3 << 11) | 20) & 0xFu; }
#define XB_SPIN(cond, bar) do { unsigned _sp = 0; while (cond) { __builtin_amdgcn_s_sleep(1); \
    if ((++_sp & 255u) == 0u) { if (xb_ld(&(bar)[XB_TMO])) break; if (_sp > XB_SPIN_CAP) { atomicAdd(&(bar)[XB_TMO], 1u); break; } } } } while (0)

struct XcdBarrier {
    unsigned* bar; unsigned x;
    volatile LAS unsigned* st;
};

__device__ __forceinline__ XcdBarrier xcd_barrier_post(unsigned* bar, volatile LAS unsigned* st) {
    XcdBarrier b; b.bar = bar; b.x = xb_xcc_id(); b.st = st;
    if (threadIdx.x == 0) (void)xb_add(&bar[XB_XCNT(b.x)], 1u);
    return b;
}
__device__ __forceinline__ void xcd_barrier_complete(unsigned* bar, unsigned x, unsigned& nloc, unsigned& nx) {
    const unsigned G = gridDim.x * gridDim.y * gridDim.z;
    unsigned sum, cnt, mine, sp = 0u;
    for (;;) {
        sum = 0u; cnt = 0u; mine = 0u;
#pragma unroll
        for (unsigned j = 0; j < 16; ++j) { const unsigned c = xb_ld(&bar[XB_XCNT(j)]); sum += c; cnt += (c > 0u) ? 1u : 0u; mine = (j == x) ? c : mine; }
        if (sum == G) break;
        __builtin_amdgcn_s_sleep(1);
        if ((++sp & 255u) == 0u) { if (xb_ld(&bar[XB_TMO])) break; if (sp > XB_SPIN_CAP) { atomicAdd(&bar[XB_TMO], 1u); break; } }
    }
    nloc = mine > 0u ? mine : 1u; nx = cnt > 0u ? cnt : 1u;
}

__device__ __forceinline__ void xcd_barrier(const XcdBarrier& b) {
    asm volatile("s_waitcnt vmcnt(0)" ::: "memory");
    __syncthreads();
    if (threadIdx.x == 0) {
        unsigned* bar = b.bar;
        __builtin_amdgcn_s_waitcnt(0);
        unsigned nloc = b.st[0], nx = b.st[1];
        if (nloc == 0u) { xcd_barrier_complete(bar, b.x, nloc, nx); b.st[0] = nloc; b.st[1] = nx; }
        const unsigned old = xb_add(&bar[XB_XSUB(b.x)], 1u);
        const unsigned gen = old / nloc;
        if (old + 1u == (gen + 1u) * nloc) {
            __builtin_amdgcn_fence(__ATOMIC_RELEASE, "agent");
            asm volatile("s_waitcnt vmcnt(0)" ::: "memory");
            const unsigned og = xb_add(&bar[XB_TOP], 1u);
            const unsigned tg = og / nx;
            if (og + 1u == (tg + 1u) * nx) xb_add(&bar[XB_TOPGEN], 1u);
            else XB_SPIN(xb_ld(&bar[XB_TOPGEN]) == tg, bar);
            __builtin_amdgcn_fence(__ATOMIC_ACQUIRE, "agent");
            xb_add(&bar[XB_XGEN(b.x)], 1u);
            asm volatile("s_waitcnt vmcnt(0)" ::: "memory");
        } else {
            XB_SPIN(xb_ld(&bar[XB_XGEN(b.x)]) == gen, bar);
            __builtin_amdgcn_fence(__ATOMIC_ACQUIRE, "agent");
            asm volatile("s_waitcnt vmcnt(0)" ::: "memory");
        }
    }
    __syncthreads();
}

template <int N, int K, int ACT>
__device__ __forceinline__ void gemm_call(const bf16* A, const bf16* Bt, bf16* O, LAS unsigned char* lds) {
    pg8::Gemm gm{A, Bt, MR, N, K};
    pg8::StaticOrder S; S.init(MR, N, gridDim.x, blockIdx.x);
    EpiOut E{O, N, ACT};
    pg8::gemm_phase<EpiOut, pg8::StaticOrder, true, true>(lds, gm, S, E);
    { const int t = ltid(); meta_gemm(A, Bt, N, K, O, ACT, blockIdx.x * NWAVES + (t >> 6), gridDim.x * NWAVES, t & 63); }
}

template <int K>
__device__ __forceinline__ void gemm_call_f32(const bf16* A, const bf16* Bt, float* lo, float* hi, LAS unsigned char* lds) {
    pg8::Gemm gm{A, Bt, MR, DM, K};
    pg8::StaticOrder S; S.init(MR, DM, gridDim.x, blockIdx.x);
    EpiF32Split E{lo, hi};
    pg8::gemm_phase<EpiF32Split, pg8::StaticOrder, true, true>(lds, gm, S, E);
    { const int t = ltid(); meta_gemm(A, Bt, DM, K, nullptr, 0, blockIdx.x * NWAVES + (t >> 6), gridDim.x * NWAVES, t & 63, lo, hi); }
}

__global__ void __launch_bounds__(NTHR, 2) trunk_fwd(Params p_unused) {
#if defined(__HIP_DEVICE_COMPILE__)
#define KP (kargs())
    extern __shared__ __attribute__((aligned(16))) unsigned char shm[];
    LAS unsigned char* lds = (LAS unsigned char*)shm;
    cg::grid_group grid = cg::this_grid();
#ifndef POST_SLEEP
#define POST_SLEEP 0
#endif
#ifdef USE_XCD_BARRIER
    volatile LAS unsigned* bst = (volatile LAS unsigned*)(lds + 131072 + 64);
    if (threadIdx.x < 2) bst[threadIdx.x] = 0u;
    __syncthreads();
    (void)xcd_barrier_post((unsigned*)(KP->ws + WS_BAR), bst);
    grid.sync();
#define GSYNC() do { XcdBarrier xb_; xb_.bar = (unsigned*)(KP->ws + WS_BAR); xb_.x = xb_xcc_id(); xb_.st = (volatile LAS unsigned*)(lds + 131072 + 64); xcd_barrier(xb_); } while (0)
#else
#define GSYNC() do { asm volatile("s_waitcnt vmcnt(0)" ::: "memory"); __threadfence(); asm volatile("s_waitcnt vmcnt(0)" ::: "memory"); grid.sync(); __threadfence(); for (int s_ = 0; s_ < POST_SLEEP; ++s_) __builtin_amdgcn_s_sleep(127); } while (0)
#endif
#define RA ((bf16*)(KP->ws + WS_RA))
#define RB ((bf16*)(KP->ws + WS_RB))
#define HM ((float*)(KP->ws + WS_HM))
    { unsigned* ctl0 = (unsigned*)(KP->ws + WS_CTL); if (blockIdx.x == 0 && threadIdx.x < 8) ctl0[64 * threadIdx.x] = 0u; }
    { const Params pc_ = *KP; conv_phase(pc_, lds, 0, gridDim.x > NB * 8 ? 1 : NL, blockIdx.x, gridDim.x); }
    norm_phase(nullptr, nullptr, nullptr, KP->x, KP->meta, KP->out, HM, KP->g_pre_mix, RA);
    GSYNC();
#ifdef DIAG_W
    const bool wbad = check_win(p);
#endif
    for (int l = 0; l < NL; ++l) {
        for (int gi = 0; gi < 4; ++gi) {
            if (gi == 1) {
                #ifdef PROBE_MIX2
                for (int rep = 0; rep < 2; ++rep) { if (rep) GSYNC(); const Params pm_ = *KP; mix_phase(pm_, l, lds, rep ? (l == 0 ? 0 : 4 + l) : -1); }
#else
                { const Params pm_ = *KP; mix_phase(pm_, l, lds); }
#endif
                GSYNC();
            }
            if (gi == 0) gemm_call<INC, DM, 0>(RA, (const bf16*)(KP->ws + WS_WIN + l * SZ_WIN), RB, lds);
            else if (gi == 1) gemm_call_f32<DM>(RA, (const bf16*)(KP->ws + WS_WOUT + l * SZ_WOUT), (float*)RB, (float*)RB + (size_t)MT * 512, lds);
            else if (gi == 2) gemm_call<DFF, DM, 1>(RA, (const bf16*)(KP->ws + WS_WUP + l * SZ_WUP), RB, lds);
            else gemm_call_f32<DFF>(RB, (const bf16*)(KP->ws + WS_WDN + l * SZ_WDN), (float*)RA, (float*)(KP->ws + WS_T2HI), lds);
            GSYNC();
            if (gi == 1) {
                norm_phase((const float*)RB, (const float*)RB + (size_t)MT * 512, KP->g_post_mix + l * DM, l == 0 ? KP->x : KP->out, l == 0 ? KP->meta : HM, KP->out, HM, KP->g_pre_ffn + l * DM, RA);
                GSYNC();
            } else if (gi == 3) {
                norm_phase((const float*)RA, (const float*)(KP->ws + WS_T2HI), KP->g_post_ffn + l * DM, KP->out, HM, KP->out, HM, l + 1 < NL ? KP->g_pre_mix + (l + 1) * DM : nullptr, RA);
                if (l + 1 < NL) GSYNC();
            }
        }
    }
#ifdef DIAG_W
    GSYNC();
    if (wbad && threadIdx.x == 0) KP->out[blockIdx.x] += 100000.f;
#endif
#undef RA
#undef RB
#undef HM
#endif
}

extern "C" void kernel_launch(void* const* d_in, const int* in_sizes, int n_in, void* d_out, int out_size, void* d_ws, size_t ws_size, hipStream_t stream) {
    static int grid = 0;
    if (grid == 0) {
        if (n_in != 22 || ws_size < WS_END) { fprintf(stderr, "kernel_launch: unexpected n_in %d / ws_size %zu (need %zu)\n", n_in, ws_size, (size_t)WS_END); grid = -1; return; }
        int dev = 0, cus = 0, per_cu = 0;
        hipGetDevice(&dev);
        hipDeviceGetAttribute(&cus, hipDeviceAttributeMultiprocessorCount, dev);
        if (hipFuncSetAttribute((const void*)trunk_fwd, hipFuncAttributeMaxDynamicSharedMemorySize, LDS_BYTES) != hipSuccess) { fprintf(stderr, "kernel_launch: hipFuncSetAttribute failed\n"); grid = -1; return; }
        if (hipOccupancyMaxActiveBlocksPerMultiprocessor(&per_cu, (const void*)trunk_fwd, NTHR, LDS_BYTES) != hipSuccess || per_cu < 1) { fprintf(stderr, "kernel_launch: occupancy query says %d\n", per_cu); per_cu = 1; }
        (void)hipGetLastError();
        grid = cus * per_cu;
        fprintf(stderr, "kernel_launch: grid %d (cus %d x %d)\n", grid, cus, per_cu);
    }
    if (grid < 0) return;
    if (hipMemsetAsync((char*)d_ws + WS_CTL, 0, WS_HM, stream) != hipSuccess) { fprintf(stderr, "kernel_launch: memset failed\n"); return; }
    Params p{};
    const float** f = (const float**)&p;
    for (int i = 0; i < 22; ++i) f[i] = (const float*)d_in[i];
    p.out = (float*)d_out; p.ws = (unsigned char*)d_ws;
    void* args[] = {&p};
    hipError_t e = hipLaunchCooperativeKernel((const void*)trunk_fwd, dim3(grid), dim3(NTHR), args, LDS_BYTES, stream);
    if (e != hipSuccess) fprintf(stderr, "cooperative launch failed: %s (grid %d)\n", hipGetErrorString(e), grid);
}
```

```cpp
#define SCAN_UNROLL 2
#define USE_XCD_BARRIER 1
#include <hip/hip_runtime.h>
#include <hip/hip_cooperative_groups.h>
#include <cstdio>
#include <cstdint>
namespace cg = cooperative_groups;
namespace pg8 {
#define PG8_LAS __attribute__((address_space(3)))
#ifndef PG8_AUX
#define PG8_AUX 2
#endif
typedef unsigned short bf16_t;
typedef short bf16x8 __attribute__((ext_vector_type(8)));
typedef float f32x4 __attribute__((ext_vector_type(4)));
typedef unsigned u32x4 __attribute__((ext_vector_type(4)));
constexpr int BM = 256, BK = 64, HALF = 128, HTB = HALF * BK * 2  , STAGE_BYTES = 8 * HTB, NXCD = 8, WGM = 8;

__host__ __device__ __forceinline__ int lds_byte(int r, int c) { const int st = (r >> 4) * 2 + (c >> 5), rr = r & 15, cc = c & 31, ob = rr * 64 + cc * 2; return st * 1024 + (ob ^ (((ob >> 9) & 1) << 5)); }
__host__ __device__ __forceinline__ void stage_rc(int b, int& R, int& C) { const int st = b / 1024, sb = b % 1024, swz = sb ^ (((sb >> 9) & 1) << 5); R = (st >> 1) * 16 + swz / 64; C = (st & 1) * 32 + (swz % 64) / 2; }
__host__ __device__ __forceinline__ int perm32(int rho) { const int n = rho >> 4, i = rho & 15; return 8 * (i >> 2) + 4 * n + (i & 3); }

struct Unit { int pm, pn; };
struct Gemm { const bf16_t* A; const bf16_t* Bt; int M, N, K; };

struct StaticOrder {
    int nM, nN, nwg, G, c;
    __host__ __device__ void init(int M, int N, int G_, int c_) { nM = M / BM; nN = N / BM; nwg = nM * nN; G = G_; c = c_; }
    __host__ __device__ bool next(int i, Unit& u) const {
        const long L = (long)i * G + c; if (L >= nwg) return false;
        int wgid = (int)L; { const int q = nwg / NXCD, r = nwg % NXCD, xcd = wgid % NXCD, off = wgid / NXCD; wgid = (xcd < r ? xcd * (q + 1) : r * (q + 1) + (xcd - r) * q) + off; }
        const int nig = WGM * nN, gid = wgid / nig, fm = gid * WGM, gsz = (nM - fm) < WGM ? (nM - fm) : WGM;
        u.pm = fm + ((wgid % nig) % gsz); u.pn = (wgid % nig) / gsz; return true;
    }
    __device__ __forceinline__ void a_ready(const Unit&) const {}
    __device__ __forceinline__ void done(const Unit&) const {}
};

__device__ __forceinline__ unsigned cvt_pk_bf16(float lo, float hi) { unsigned r; asm volatile("v_cvt_pk_bf16_f32 %0, %1, %2" : "=v"(r) : "v"(lo), "v"(hi)); return r; }
typedef float f32x2 __attribute__((ext_vector_type(2)));
template <class Epi, class Sched, bool ALIGN_EPI = false, bool SP2 = false>
__device__ __forceinline__ void gemm_phase(PG8_LAS unsigned char* lds, const Gemm g, const Sched& S, const Epi& E) {
    int tid_ = threadIdx.x; asm volatile("" : "+v"(tid_));
    const int tid = tid_, wid = __builtin_amdgcn_readfirstlane(tid >> 6), lane = tid & 63, wr = wid >> 2, wc = wid & 3, fr = lane & 15, fq = lane >> 4;
    const int K = g.K, nt = K / BK;
    unsigned voffA[2], voffB[2];
#pragma unroll
    for (int i = 0; i < 2; ++i) { int R, C; stage_rc(tid * 16 + i * 8192, R, C); const int Rb = Epi::PERM ? ((R & ~31) + perm32(R & 31)) : R;
        voffA[i] = (unsigned)(R * K + C) * 2u; voffB[i] = (unsigned)(Rb * K + C) * 2u; }
    const size_t kstep = (size_t)(BK * 2);
    const size_t hstep = (size_t)HALF * K * 2;
    const size_t tstep = 2 * hstep;
    const unsigned ldsw = (unsigned)wid * 1024u;
    const int aoff = lds_byte(wr * 64 + fr, fq * 8), boff = lds_byte(wc * 32 + fr, fq * 8);
#define PG8_SA(b, h) (((b) * 2 + (h)) * HTB)
#define PG8_SB(b, h) ((4 + (b) * 2 + (h)) * HTB)
#define PG8_STAGE(bufoff, gbase, voff) do { _Pragma("unroll") for (int _i = 0; _i < 2; ++_i) \
        __builtin_amdgcn_global_load_lds((const unsigned*)((const char*)(gbase) + (voff)[_i]), (PG8_LAS unsigned*)(lds + (bufoff) + ldsw + _i * 8192), 16, 0, 0); } while (0)
#define PG8_LDA(dst, b, h) do { _Pragma("unroll") for (int m = 0; m < 4; ++m) _Pragma("unroll") for (int k = 0; k < 2; ++k) dst[m][k] = *(const PG8_LAS bf16x8*)(lds + PG8_SA(b, h) + aoff + m * 2048 + k * 1024); } while (0)
#define PG8_LDB(dst, b, h) do { _Pragma("unroll") for (int n = 0; n < 2; ++n) _Pragma("unroll") for (int k = 0; k < 2; ++k) dst[n][k] = *(const PG8_LAS bf16x8*)(lds + PG8_SB(b, h) + boff + n * 2048 + k * 1024); } while (0)
#define PG8_MMA(ai, bj, At, Bt) do { __builtin_amdgcn_s_setprio(1); _Pragma("unroll") for (int m = 0; m < 4; ++m) _Pragma("unroll") for (int n = 0; n < 2; ++n) _Pragma("unroll") for (int k = 0; k < 2; ++k) \
        acc[ai][bj][m][n] = __builtin_amdgcn_mfma_f32_16x16x32_bf16(Bt[n][k], At[m][k], acc[ai][bj][m][n], 0, 0, 0); __builtin_amdgcn_s_setprio(0); } while (0)
#define PG8_WAIT_V(n) asm volatile("s_waitcnt vmcnt(" #n ")" ::: "memory")
#define PG8_WAIT_L(n) asm volatile("s_waitcnt lgkmcnt(" #n ")" ::: "memory")
#define PG8_BAR __builtin_amdgcn_s_barrier()
#define PG8_SCHED __builtin_amdgcn_sched_barrier(0)
    Unit cur, nxt; int ui = 0;
    if (!S.next(0, cur)) return;
    f32x4 acc[2][2][4][2];
#pragma unroll
    for (int a = 0; a < 2; ++a)
#pragma unroll
        for (int b = 0; b < 2; ++b)
#pragma unroll
            for (int m = 0; m < 4; ++m)
#pragma unroll
                for (int n = 0; n < 2; ++n) acc[a][b][m][n] = (f32x4){0.f, 0.f, 0.f, 0.f};
    bf16x8 At[4][2], B0[2][2], B1[2][2];
    const char* cA = (const char*)g.A + (size_t)cur.pm * tstep; const char* cB = (const char*)g.Bt + (size_t)cur.pn * tstep;
    S.a_ready(cur);
    if constexpr (SP2) {
        PG8_STAGE(PG8_SB(0, 0), cB, voffB); PG8_STAGE(PG8_SB(0, 1), cB + hstep, voffB); PG8_STAGE(PG8_SA(0, 0), cA, voffA); PG8_STAGE(PG8_SA(0, 1), cA + hstep, voffA);
        if (wr == 1) PG8_BAR;
        PG8_WAIT_V(2); PG8_BAR;
        PG8_STAGE(PG8_SB(1, 0), cB + kstep, voffB); PG8_STAGE(PG8_SA(1, 0), cA + kstep, voffA); PG8_STAGE(PG8_SB(1, 1), cB + hstep + kstep, voffB);
        PG8_WAIT_V(6); PG8_BAR;
    } else {
        PG8_STAGE(PG8_SB(0, 0), cB, voffB); PG8_STAGE(PG8_SA(0, 0), cA, voffA); PG8_STAGE(PG8_SB(0, 1), cB + hstep, voffB); PG8_STAGE(PG8_SA(0, 1), cA + hstep, voffA);
        if (wr == 1) PG8_BAR;
        PG8_WAIT_V(4); PG8_BAR;
        PG8_STAGE(PG8_SB(1, 0), cB + kstep, voffB); PG8_STAGE(PG8_SA(1, 0), cA + kstep, voffA); PG8_STAGE(PG8_SB(1, 1), cB + hstep + kstep, voffB);
        PG8_WAIT_V(6); PG8_BAR;
    }
    for (;;) {
        const bool has_next = S.next(ui + 1, nxt);
        const char* nA = has_next ? (const char*)g.A + (size_t)nxt.pm * tstep : cA; const char* nB = has_next ? (const char*)g.Bt + (size_t)nxt.pn * tstep : cB;
        for (int t = 0; t < nt; t += 2) {
            const bool last = (t == nt - 2);
            const char* a1 = cA + (size_t)(t + 1) * kstep;
            const char* a2 = last ? nA : cA + (size_t)(t + 2) * kstep; const char* b2 = last ? nB : cB + (size_t)(t + 2) * kstep;
            const char* a3 = a2 + kstep; const char* b3 = b2 + kstep;
            if (last && has_next) S.a_ready(nxt);
            if constexpr (SP2) {
            PG8_LDB(B0, 0, 0); PG8_LDB(B1, 0, 1); PG8_SCHED; PG8_LDA(At, 0, 0); PG8_STAGE(PG8_SA(1, 1), a1 + hstep, voffA);
            PG8_WAIT_V(8); PG8_WAIT_L(0); PG8_BAR; PG8_MMA(0, 0, At, B0); PG8_MMA(0, 1, At, B1); PG8_BAR; PG8_SCHED;
            PG8_LDA(At, 0, 1); PG8_STAGE(PG8_SB(0, 0), b2, voffB); PG8_STAGE(PG8_SB(0, 1), b2 + hstep, voffB); PG8_STAGE(PG8_SA(0, 0), a2, voffA);
            PG8_WAIT_V(8); PG8_WAIT_L(0); PG8_BAR; PG8_MMA(1, 0, At, B0); PG8_MMA(1, 1, At, B1); PG8_BAR; PG8_SCHED;
            PG8_LDB(B0, 1, 0); PG8_LDB(B1, 1, 1); PG8_SCHED; PG8_LDA(At, 1, 0); PG8_STAGE(PG8_SA(0, 1), a2 + hstep, voffA);
            PG8_WAIT_V(8); PG8_WAIT_L(0); PG8_BAR; PG8_MMA(0, 0, At, B0); PG8_MMA(0, 1, At, B1); PG8_BAR; PG8_SCHED;
            PG8_LDA(At, 1, 1); PG8_STAGE(PG8_SB(1, 0), b3, voffB); PG8_STAGE(PG8_SB(1, 1), b3 + hstep, voffB); PG8_STAGE(PG8_SA(1, 0), a3, voffA);
            PG8_WAIT_V(8); PG8_WAIT_L(0); PG8_BAR; PG8_MMA(1, 0, At, B0); PG8_MMA(1, 1, At, B1); PG8_BAR; PG8_SCHED;
            } else {
            PG8_LDB(B0, 0, 0); PG8_SCHED; PG8_LDA(At, 0, 0); PG8_STAGE(PG8_SA(1, 1), a1 + hstep, voffA);
            PG8_WAIT_L(8); PG8_BAR; PG8_WAIT_L(0); PG8_MMA(0, 0, At, B0); PG8_BAR; PG8_SCHED;
            PG8_LDB(B1, 0, 1); PG8_STAGE(PG8_SB(0, 0), b2, voffB);
            PG8_BAR; PG8_WAIT_L(0); PG8_MMA(0, 1, At, B1); PG8_BAR;
            PG8_LDA(At, 0, 1); PG8_STAGE(PG8_SA(0, 0), a2, voffA);
            PG8_BAR; PG8_WAIT_L(0); PG8_MMA(1, 0, At, B0); PG8_BAR; PG8_SCHED;
            PG8_STAGE(PG8_SB(0, 1), b2 + hstep, voffB);
            PG8_WAIT_V(6); PG8_BAR; PG8_MMA(1, 1, At, B1); PG8_BAR;
            PG8_LDB(B0, 1, 0); PG8_SCHED; PG8_LDA(At, 1, 0); PG8_STAGE(PG8_SA(0, 1), a2 + hstep, voffA);
            PG8_WAIT_L(8); PG8_BAR; PG8_WAIT_L(0); PG8_MMA(0, 0, At, B0); PG8_BAR; PG8_SCHED;
            PG8_LDB(B1, 1, 1); PG8_STAGE(PG8_SB(1, 0), b3, voffB);
            PG8_BAR; PG8_WAIT_L(0); PG8_MMA(0, 1, At, B1); PG8_BAR;
            PG8_LDA(At, 1, 1); PG8_STAGE(PG8_SA(1, 0), a3, voffA);
            PG8_BAR; PG8_WAIT_L(0); PG8_MMA(1, 0, At, B0); PG8_BAR; PG8_SCHED;
            PG8_STAGE(PG8_SB(1, 1), b3 + hstep, voffB);
            PG8_WAIT_V(6); PG8_BAR; PG8_MMA(1, 1, At, B1); PG8_BAR;
            }
        }
        if constexpr (ALIGN_EPI) { if (wr == 0) PG8_BAR; }
        if constexpr (!Epi::AFTER_DRAIN) { E(acc, cur, wr, wc, fr, fq); S.done(cur); }
        if (!has_next) break;
#pragma unroll
        for (int a = 0; a < 2; ++a)
#pragma unroll
            for (int b = 0; b < 2; ++b)
#pragma unroll
                for (int m = 0; m < 4; ++m)
#pragma unroll
                    for (int n = 0; n < 2; ++n) acc[a][b][m][n] = (f32x4){0.f, 0.f, 0.f, 0.f};
        cur = nxt; cA = nA; cB = nB; ++ui;
        if constexpr (ALIGN_EPI) { if (wr == 1) PG8_BAR; }
    }
    PG8_WAIT_V(0);
    if constexpr (!ALIGN_EPI) { if (wr == 0) PG8_BAR; }
    PG8_BAR;
    if constexpr (Epi::AFTER_DRAIN) { E.fused(acc, cur, wr, wc, fr, fq, lds, wid, lane); S.done(cur); }
#undef PG8_SA
#undef PG8_SB
#undef PG8_STAGE
#undef PG8_LDA
#undef PG8_LDB
#undef PG8_MMA
#undef PG8_WAIT_V
#undef PG8_WAIT_L
#undef PG8_BAR
#undef PG8_SCHED
}
}


#define LAS __attribute__((address_space(3)))
typedef unsigned short bf16;
typedef short bf16x8 __attribute__((ext_vector_type(8)));
typedef float f32x4 __attribute__((ext_vector_type(4)));
typedef float f32x2 __attribute__((ext_vector_type(2)));
typedef unsigned u32x4 __attribute__((ext_vector_type(4)));
typedef unsigned u32x2 __attribute__((ext_vector_type(2)));

constexpr int NB = 16, SEQ = 2048, NMETA = 16, TT = SEQ + NMETA, DM = 1024, DFF = 4096, NL = 4;
constexpr int MR = NB * SEQ;
constexpr int MT = MR + NMETA;
constexpr int INC = 3328;
constexpr int C_R = 0, C_K = 512, C_V = 1024, C_DW = 1536, C_DA = 1600, C_DG = 1664, C_Q = 1792, C_SK = 2304, C_SV = 2816;
constexpr int NWAVES = 8, NTHR = 512;
constexpr int LDS_BYTES = 147456;

constexpr size_t WS_CTL = 0;
constexpr size_t WS_BAR = 4096;
constexpr size_t WS_HM = 20480;
constexpr size_t WS_WIN = WS_HM + (size_t)NMETA * DM * 4;
constexpr size_t SZ_WIN = (size_t)INC * DM * 2;
constexpr size_t WS_WOUT = WS_WIN + NL * SZ_WIN;
constexpr size_t SZ_WOUT = (size_t)DM * DM * 2;
constexpr size_t WS_WUP = WS_WOUT + NL * SZ_WOUT;
constexpr size_t SZ_WUP = (size_t)DFF * DM * 2;
constexpr size_t WS_WDN = WS_WUP + NL * SZ_WUP;
constexpr size_t SZ_WDN = SZ_WUP;
constexpr size_t WS_WD = WS_WDN + NL * SZ_WDN;
constexpr size_t SZ_WD = (size_t)512 * 64 * 2;
constexpr size_t WS_WA = WS_WD + NL * SZ_WD;
constexpr size_t WS_WG = WS_WA + NL * SZ_WD;
constexpr size_t SZ_WG = (size_t)512 * 128 * 2;
constexpr size_t WS_RA = WS_WG + NL * SZ_WG;
constexpr size_t SZ_RA = (size_t)MT * DM * 2;
constexpr size_t WS_RB = WS_RA + SZ_RA;
constexpr size_t SZ_RB = (size_t)MT * DFF * 2;
constexpr size_t WS_T2HI = WS_RB + SZ_RB;
constexpr size_t WS_END = WS_T2HI + (size_t)MT * 512 * 4;

struct Params {
    const float* x; const float* meta; const float* g_pre_mix; const float* g_post_mix; const float* g_pre_ffn; const float* g_post_ffn;
    const float* w_in; const float* mu; const float* w_decay_up; const float* decay_bias; const float* w_a_up; const float* a_bias; const float* w_g_up;
    const float* k_k; const float* k_a; const float* r_k; const float* lnx_gain; const float* lnx_bias; const float* sb_gain;
    const float* w_out; const float* w_up; const float* w_dn;
    float* out; unsigned char* ws;
};

typedef const __attribute__((address_space(4))) Params* KParams;
__device__ __forceinline__ KParams kargs() { KParams k = (KParams)__builtin_amdgcn_kernarg_segment_ptr(); asm volatile("" : "+s"(k)); return k; }
__device__ __forceinline__ int ltid() { int t = threadIdx.x; asm volatile("" : "+v"(t)); return t; }
__device__ __forceinline__ unsigned f2bf(float f) { unsigned u = __builtin_bit_cast(unsigned, f); return (u + 0x7fffu + ((u >> 16) & 1u)) >> 16; }
__device__ __forceinline__ unsigned pk2(float lo, float hi) { unsigned r; asm volatile("v_cvt_pk_bf16_f32 %0, %1, %2" : "=v"(r) : "v"(lo), "v"(hi)); return r; }
__device__ __forceinline__ float bflo(unsigned u) { return __builtin_bit_cast(float, u << 16); }
__device__ __forceinline__ float bfhi(unsigned u) { return __builtin_bit_cast(float, u & 0xffff0000u); }
__device__ __forceinline__ int tokrow(int b, int t) { return t < NMETA ? MR + t : b * SEQ + (t - NMETA); }
__device__ __forceinline__ float wave_sum(float v) {
#pragma unroll
    for (int o = 1; o < 64; o <<= 1) v += __shfl_xor(v, o);
    return v;
}

template <int CTRL> __device__ __forceinline__ float dppf(float x) {
    return __builtin_bit_cast(float, __builtin_amdgcn_update_dpp(0, __builtin_bit_cast(int, x), CTRL, 0xF, 0xF, true));
}
__device__ __forceinline__ float sum8(float v) {
    v += dppf<0xB1>(v);
    v += dppf<0x4E>(v);
    v += dppf<0x141>(v);
    return v;
}
__device__ __forceinline__ float sum16(float v) {
    v += dppf<0xB1>(v);
    v += dppf<0x4E>(v);
    v += dppf<0x141>(v);
    v += dppf<0x140>(v);
    return v;
}
__device__ __forceinline__ float fast_exp(float x) { return __builtin_amdgcn_exp2f(x * 1.4426950408889634f); }
__device__ __forceinline__ float fast_log(float x) { return __builtin_amdgcn_logf(x) * 0.6931471805599453f; }
__device__ __forceinline__ float softplusf(float z) { return fmaxf(z, 0.f) + fast_log(1.f + fast_exp(-fabsf(z))); }
__device__ __forceinline__ float sigmoidf_(float z) { return __builtin_amdgcn_rcpf(1.f + fast_exp(-z)); }

template <class T> __device__ __forceinline__ T ldnt(const void* p) { return __builtin_nontemporal_load((const T*)p); }

struct EpiOut {
    static constexpr bool PERM = true, AFTER_DRAIN = false;
    bf16* O; int ldc; int act;
    __device__ __forceinline__ void operator()(const f32x4 (&acc)[2][2][4][2], const pg8::Unit& u, int wr, int wc, int fr, int fq) const {
        const int row0 = u.pm * 256 + wr * 64 + fr, col0 = u.pn * 256 + wc * 32 + 8 * fq;
#pragma unroll
        for (int ai = 0; ai < 2; ++ai)
#pragma unroll
            for (int m = 0; m < 4; ++m) { bf16* rowp = O + (size_t)(row0 + ai * 128 + m * 16) * ldc + col0;
#pragma unroll
                for (int bj = 0; bj < 2; ++bj) { f32x4 v0 = acc[ai][bj][m][0], v1 = acc[ai][bj][m][1];
                    if (act) {
#pragma unroll
                        for (int e = 0; e < 4; ++e) { float a = fmaxf(v0[e], 0.f), b = fmaxf(v1[e], 0.f); v0[e] = a * a; v1[e] = b * b; } }
                    u32x4 w; w.x = pk2(v0[0], v0[1]); w.y = pk2(v0[2], v0[3]); w.z = pk2(v1[0], v1[1]); w.w = pk2(v1[2], v1[3]);
                    *(u32x4*)(rowp + bj * 128) = w; } }
    }
};

struct EpiF32Split {
    static constexpr bool PERM = true, AFTER_DRAIN = false;
    float* lo; float* hi;
    __device__ __forceinline__ void operator()(const f32x4 (&acc)[2][2][4][2], const pg8::Unit& u, int wr, int wc, int fr, int fq) const {
        const int row0 = u.pm * 256 + wr * 64 + fr, col0 = (u.pn & 1) * 256 + wc * 32 + 8 * fq;
        float* base = (u.pn < 2) ? lo : hi;
#pragma unroll
        for (int ai = 0; ai < 2; ++ai)
#pragma unroll
            for (int m = 0; m < 4; ++m) { float* rowp = base + (size_t)(row0 + ai * 128 + m * 16) * 512 + col0;
#pragma unroll
                for (int bj = 0; bj < 2; ++bj) { *(f32x4*)(rowp + bj * 128) = acc[ai][bj][m][0]; *(f32x4*)(rowp + bj * 128 + 4) = acc[ai][bj][m][1]; } }
    }
};

__device__ __forceinline__ void meta_gemm(const bf16* A, const bf16* Bt, int N, int K, bf16* O, int act, LAS unsigned char* lds, int tid, float* flo = nullptr, float* fhi = nullptr) {
    const int lane = tid & 63, wave = tid >> 6, i = lane & 15, g = lane >> 4, kper = K / NWAVES;
    LAS f32x4* red = (LAS f32x4*)lds;
    for (int task = (int)gridDim.x - 1 - (int)blockIdx.x; task < N / 16; task += (int)gridDim.x) {
        const int n0 = task * 16;
        const bf16* ap = Bt + (size_t)(n0 + i) * K + wave * kper + 8 * g;
        const bf16* bp = A + (size_t)(MR + i) * K + wave * kper + 8 * g;
        f32x4 acc = {0.f, 0.f, 0.f, 0.f};
#pragma unroll 4
        for (int k0 = 0; k0 < kper; k0 += 32) {
            bf16x8 a = *(const bf16x8*)(ap + k0), b = *(const bf16x8*)(bp + k0);
            acc = __builtin_amdgcn_mfma_f32_16x16x32_bf16(a, b, acc, 0, 0, 0);
        }
        __syncthreads();
        red[wave * 64 + lane] = acc;
        __syncthreads();
        if (wave == 0) {
            f32x4 sum = red[lane];
#pragma unroll
            for (int w = 1; w < NWAVES; ++w) sum = sum + red[w * 64 + lane];
            if (act) {
#pragma unroll
                for (int e = 0; e < 4; ++e) { float a = fmaxf(sum[e], 0.f); sum[e] = a * a; } }
            if (flo) { float* base = (n0 < 512) ? flo : fhi; *(f32x4*)(base + (size_t)(MR + i) * 512 + (n0 & 511) + 4 * g) = sum; }
            else { u32x2 w; w.x = pk2(sum[0], sum[1]); w.y = pk2(sum[2], sum[3]); *(u32x2*)(O + (size_t)(MR + i) * N + n0 + 4 * g) = w; }
        }
    }
}

__device__ __forceinline__ void transpose_item(const float* W, int K, int N, bf16* WT, LAS float* scr, int item, int lane) {
    const int nblk = N / 32, kb = item / nblk, nb = item % nblk, k0 = 64 * kb, n0 = 32 * nb;
#pragma unroll 8
    for (int i = 0; i < 32; ++i) { const int kk = 2 * i + (lane >> 5); scr[kk * 33 + (lane & 31)] = W[(size_t)(k0 + kk) * N + n0 + (lane & 31)]; }
    asm volatile("s_waitcnt lgkmcnt(0)" ::: "memory");
    const int c = lane & 7;
#pragma unroll
    for (int j = 0; j < 4; ++j) { const int n = (lane >> 3) + 8 * j; const LAS float* s = scr + (8 * c) * 33 + n;
        u32x4 o; o.x = pk2(s[0 * 33], s[1 * 33]); o.y = pk2(s[2 * 33], s[3 * 33]); o.z = pk2(s[4 * 33], s[5 * 33]); o.w = pk2(s[6 * 33], s[7 * 33]);
        *(u32x4*)(WT + (size_t)(n0 + n) * K + k0 + 8 * c) = o; }
    asm volatile("s_waitcnt lgkmcnt(0)" ::: "memory");
}
__device__ __forceinline__ void conv_phase(const Params& p, LAS unsigned char* lds, int it_lo_layers, int it_hi_layers, int wg, int nwg) {
    const int t_ = ltid(), lane = t_ & 63, wave = t_ >> 6, gw = wg * NWAVES + wave, ngw = nwg * NWAVES;
    LAS float* scr = (LAS float*)(lds + wave * 16384);
    constexpr int I_IN = 16 * 104, I_OUT = 16 * 32, I_UP = 16 * 128, I_DN = 64 * 32, I_D = 16, I_A = 16, I_G = 32;
    constexpr int PER = I_IN + I_OUT + I_UP + I_DN + I_D + I_A + I_G;
    for (int it = it_lo_layers * PER + gw; it < it_hi_layers * PER; it += ngw) {
        const int l = it / PER; int r = it % PER;
        if (r < I_IN) { transpose_item(p.w_in + (size_t)l * DM * INC, DM, INC, (bf16*)(p.ws + WS_WIN + l * SZ_WIN), scr, r, lane); continue; } r -= I_IN;
        if (r < I_OUT) { transpose_item(p.w_out + (size_t)l * DM * DM, DM, DM, (bf16*)(p.ws + WS_WOUT + l * SZ_WOUT), scr, r, lane); continue; } r -= I_OUT;
        if (r < I_UP) { transpose_item(p.w_up + (size_t)l * DM * DFF, DM, DFF, (bf16*)(p.ws + WS_WUP + l * SZ_WUP), scr, r, lane); continue; } r -= I_UP;
        if (r < I_DN) { transpose_item(p.w_dn + (size_t)l * DFF * DM, DFF, DM, (bf16*)(p.ws + WS_WDN + l * SZ_WDN), scr, r, lane); continue; } r -= I_DN;
        if (r < I_D) { transpose_item(p.w_decay_up + (size_t)l * 64 * 512, 64, 512, (bf16*)(p.ws + WS_WD + l * SZ_WD), scr, r, lane); continue; } r -= I_D;
        if (r < I_A) { transpose_item(p.w_a_up + (size_t)l * 64 * 512, 64, 512, (bf16*)(p.ws + WS_WA + l * SZ_WD), scr, r, lane); continue; } r -= I_A;
        transpose_item(p.w_g_up + (size_t)l * 128 * 512, 128, 512, (bf16*)(p.ws + WS_WG + l * SZ_WG), scr, r, lane);
    }
}

__device__ __forceinline__ void norm_phase(const float* T, const float* Thi, const float* g1, const float* hin_real, const float* hin_meta, float* hout_real, float* hout_meta,
                                           const float* g2, bf16* xn) {
    const int t_ = ltid(), lane = t_ & 63, gw = blockIdx.x * NWAVES + (t_ >> 6), ngw = gridDim.x * NWAVES;
    for (int m = gw; m < MT; m += ngw) {
        const float* hi = m < MR ? hin_real + (size_t)m * DM : hin_meta + (size_t)(m - MR) * DM;
        float* ho = m < MR ? hout_real + (size_t)m * DM : hout_meta + (size_t)(m - MR) * DM;
        f32x4 h[4];
#pragma unroll
        for (int j = 0; j < 4; ++j) h[j] = *((const f32x4*)hi + lane + 64 * j);
        if (T) {
            f32x4 t[4]; float ss = 0.f;
#pragma unroll
            for (int j = 0; j < 4; ++j) { t[j] = *((const f32x4*)((j < 2 ? T : Thi) + (size_t)m * 512) + lane + 64 * (j & 1));
                ss += (t[j].x * t[j].x + t[j].y * t[j].y) + (t[j].z * t[j].z + t[j].w * t[j].w); }
            const float r1 = 1.f / sqrtf(wave_sum(ss) * (1.f / DM) + 1e-6f);
#pragma unroll
            for (int j = 0; j < 4; ++j) { f32x4 gg = *((const f32x4*)g1 + lane + 64 * j); h[j] = h[j] + t[j] * r1 * gg; *((f32x4*)ho + lane + 64 * j) = h[j]; }
        }
        if (g2) {
            float ss = 0.f;
#pragma unroll
            for (int j = 0; j < 4; ++j) ss += (h[j].x * h[j].x + h[j].y * h[j].y) + (h[j].z * h[j].z + h[j].w * h[j].w);
            const float r2 = 1.f / sqrtf(wave_sum(ss) * (1.f / DM) + 1e-6f);
            u32x2* o = (u32x2*)(xn + (size_t)m * DM) + lane;
#pragma unroll
            for (int j = 0; j < 4; ++j) { f32x4 gg = *((const f32x4*)g2 + lane + 64 * j); f32x4 v = h[j] * r2 * gg;
                u32x2 w; w.x = pk2(v.x, v.y); w.y = pk2(v.z, v.w); o[64 * j] = w; }
        }
    }
}

constexpr int RW_CH = 32;
constexpr int RW_R = 0, RW_W = 8192, RW_K = 16384, RW_V = 24576, RW_KKN = 32768, RW_B = 40960, RW_Y = 49152, RW_G = 57344;
constexpr int RW_TD = 65536, RW_DA = 70144, RW_SG = 74752, RW_BON = 83456;

__device__ __forceinline__ void rwkv_chain(const Params& p, int l, int b, int h, LAS unsigned char* lds, int tid) {
    const int wave = tid >> 6, lane = tid & 63;
    const bf16* P = (const bf16*)(p.ws + WS_RB);
    bf16* Yo = (bf16*)(p.ws + WS_RA);
    LAS float* R = (LAS float*)(lds + RW_R); LAS float* W = (LAS float*)(lds + RW_W); LAS float* Kx = (LAS float*)(lds + RW_K); LAS float* V = (LAS float*)(lds + RW_V);
    LAS float* KKN = (LAS float*)(lds + RW_KKN); LAS float* BV = (LAS float*)(lds + RW_B); LAS float* Y = (LAS float*)(lds + RW_Y); LAS float* G = (LAS float*)(lds + RW_G);
    LAS bf16* TD = (LAS bf16*)(lds + RW_TD); LAS bf16* DA = (LAS bf16*)(lds + RW_DA); LAS bf16* SG = (LAS bf16*)(lds + RW_SG); LAS float* BON = (LAS float*)(lds + RW_BON);
    const float* mu = p.mu + (size_t)l * 1792;
    const int mt = wave & 1, nt = wave >> 1, fi = lane & 15, fg = lane >> 4;
    bf16x8 wdF[2], waF[2], wgF[4];
    {
        const bf16* wd = (const bf16*)(p.ws + WS_WD + l * SZ_WD) + (size_t)(h * 64 + nt * 16 + fi) * 64 + 8 * fg;
        const bf16* wa = (const bf16*)(p.ws + WS_WA + l * SZ_WD) + (size_t)(h * 64 + nt * 16 + fi) * 64 + 8 * fg;
        const bf16* wg = (const bf16*)(p.ws + WS_WG + l * SZ_WG) + (size_t)(h * 64 + nt * 16 + fi) * 128 + 8 * fg;
        wdF[0] = *(const bf16x8*)wd; wdF[1] = *(const bf16x8*)(wd + 32);
        waF[0] = *(const bf16x8*)wa; waF[1] = *(const bf16x8*)(wa + 32);
#pragma unroll
        for (int k = 0; k < 4; ++k) wgF[k] = *(const bf16x8*)(wg + 32 * k);
    }
    const int cB = h * 64 + nt * 16 + fi;
    const float dbias = p.decay_bias[l * 512 + cB], abias = p.a_bias[l * 512 + cB];
    const int tokC = tid >> 4, ch4 = (tid & 15) * 4, cC = h * 64 + ch4;
    const f32x4 kkv = *(const f32x4*)(p.k_k + l * 512 + cC), kav = *(const f32x4*)(p.k_a + l * 512 + cC), rkv = *(const f32x4*)(p.r_k + l * 512 + cC);
    const f32x4 lgv = *(const f32x4*)(p.lnx_gain + l * 512 + cC), lbv = *(const f32x4*)(p.lnx_bias + l * 512 + cC);
    const int vrow = (tid >> 3) & 31, kq = tid & 7;
    f32x2 S[2][4];
#pragma unroll
    for (int q = 0; q < 2; ++q)
#pragma unroll
        for (int j = 0; j < 4; ++j) S[q][j] = (f32x2){0.f, 0.f};

    u32x4 pc[4], pp[4];
    LAS float* MU = (LAS float*)(lds + 83968);
    if (tid < 448) { const int gi = tid >> 3; const int col = gi < 24 ? (gi >> 3) * 512 + h * 64 + (gi & 7) * 8 : C_DW + (gi - 24) * 8; MU[tid] = mu[col + (tid & 7)]; }
#pragma unroll
    for (int k = 0; k < 4; ++k) { pc[k] = (u32x4){0u, 0u, 0u, 0u}; pp[k] = pc[k]; }
#define RW_IK(k) (((tid + NTHR * (k)) * 4682) >> 18)
#define RW_GIK(k) ((tid + NTHR * (k)) - 56 * RW_IK(k))
#define RW_COL(gi) ((gi) < 24 ? ((gi) >> 3) * 512 + h * 64 + ((gi) & 7) * 8 : C_DW + ((gi) - 24) * 8)
#define RW_ISSUE(T0, NT) do { _Pragma("unroll") for (int k = 0; k < 4; ++k) { if (tid + NTHR * k < (NT) * 56) { const int t_ = (T0) + RW_IK(k); const int c_ = RW_COL(RW_GIK(k)); \
        pc[k] = ldnt<u32x4>(P + (size_t)tokrow(b, t_) * INC + c_); pp[k] = (u32x4){0u, 0u, 0u, 0u}; \
        if (t_ > 0) pp[k] = ldnt<u32x4>(P + (size_t)tokrow(b, t_ - 1) * INC + c_); } } } while (0)
    RW_ISSUE(0, NMETA);
    __syncthreads();
    for (int t0 = 0; t0 < TT; ) {
        const int ntok = (t0 == 0) ? NMETA : RW_CH;
#pragma unroll
        for (int k = 0; k < 4; ++k) {
            if (tid + NTHR * k < ntok * 56) {
                const int i = RW_IK(k), gi = RW_GIK(k);
                float xv[8];
                {
                    const unsigned cu[4] = {pc[k].x, pc[k].y, pc[k].z, pc[k].w}, pu[4] = {pp[k].x, pp[k].y, pp[k].z, pp[k].w};
                    const f32x4 ma = *(const LAS f32x4*)(MU + gi * 8), mb = *(const LAS f32x4*)(MU + gi * 8 + 4);
                    const float mm[8] = {ma.x, ma.y, ma.z, ma.w, mb.x, mb.y, mb.z, mb.w};
#pragma unroll
                    for (int e = 0; e < 4; ++e) { float c0 = bflo(cu[e]), c1 = bfhi(cu[e]), q0 = bflo(pu[e]), q1 = bfhi(pu[e]);
                        xv[2 * e] = c0 + (q0 - c0) * mm[2 * e]; xv[2 * e + 1] = c1 + (q1 - c1) * mm[2 * e + 1]; }
                }
                if (gi < 24) {
                    LAS float* dst = (gi < 8 ? R : (gi < 16 ? Kx : V)) + i * 64 + (gi & 7) * 8;
                    *(LAS f32x4*)dst = (f32x4){xv[0], xv[1], xv[2], xv[3]}; *(LAS f32x4*)(dst + 4) = (f32x4){xv[4], xv[5], xv[6], xv[7]};
                } else if (gi >= 32 && gi < 40) {
                    u32x4 w; w.x = pk2(xv[0], xv[1]); w.y = pk2(xv[2], xv[3]); w.z = pk2(xv[4], xv[5]); w.w = pk2(xv[6], xv[7]);
                    *(LAS u32x4*)(DA + i * 72 + (gi - 32) * 8) = w;
                } else {
                    const bool th = gi < 32; const float sc = th ? 2.f : 1.f, ka = th ? 2.f : 1.f, kb = th ? -1.f : 0.f;
                    float tv[8];
#pragma unroll
                    for (int e = 0; e < 8; ++e) tv[e] = ka * sigmoidf_(sc * xv[e]) + kb;
                    u32x4 w; w.x = pk2(tv[0], tv[1]); w.y = pk2(tv[2], tv[3]); w.z = pk2(tv[4], tv[5]); w.w = pk2(tv[6], tv[7]);
                    LAS bf16* dstb = th ? TD + i * 72 + (gi - 24) * 8 : SG + i * 136 + (gi - 40) * 8;
                    *(LAS u32x4*)dstb = w;
                }
            }
        }
        __syncthreads();
#ifndef ISSUE_LATE
        if (t0 + ntok < TT) RW_ISSUE(t0 + ntok, RW_CH);
#endif
        {
            f32x4 ad = {0.f, 0.f, 0.f, 0.f}, aa = ad, ag = ad;
#pragma unroll
            for (int ks = 0; ks < 2; ++ks) {
                bf16x8 fa = *(const LAS bf16x8*)(TD + (16 * mt + fi) * 72 + 32 * ks + 8 * fg);
                ad = __builtin_amdgcn_mfma_f32_16x16x32_bf16(fa, wdF[ks], ad, 0, 0, 0);
                bf16x8 fb = *(const LAS bf16x8*)(DA + (16 * mt + fi) * 72 + 32 * ks + 8 * fg);
                aa = __builtin_amdgcn_mfma_f32_16x16x32_bf16(fb, waF[ks], aa, 0, 0, 0);
            }
#pragma unroll
            for (int ks = 0; ks < 4; ++ks) {
                bf16x8 fc = *(const LAS bf16x8*)(SG + (16 * mt + fi) * 136 + 32 * ks + 8 * fg);
                ag = __builtin_amdgcn_mfma_f32_16x16x32_bf16(fc, wgF[ks], ag, 0, 0, 0);
            }
#pragma unroll
            for (int r = 0; r < 4; ++r) {
                const int tok = 16 * mt + 4 * fg + r, o = tok * 64 + nt * 16 + fi;
                const float xd = dbias + ad[r];
                const float wlog = -softplusf(-xd) - 0.5f;
                W[o] = fast_exp(-fast_exp(wlog));
                BV[o] = sigmoidf_(abias + aa[r]);
                G[o] = ag[r];
            }
        }
        __syncthreads();
        {
            const int o = tokC * 64 + ch4;
            const f32x4 k = *(const LAS f32x4*)(Kx + o), a = *(const LAS f32x4*)(BV + o), r = *(const LAS f32x4*)(R + o);
            f32x4 kk = k * kkv;
            const float ss = sum16((kk.x * kk.x + kk.y * kk.y) + (kk.z * kk.z + kk.w * kk.w));
            const float inv = 1.f / sqrtf(ss + 1e-12f);
            kk = kk * inv;
            const f32x4 km = k * (1.f + (a - 1.f) * kav);
            const f32x4 bb = r * km * rkv;
            const float bon = sum16((bb.x + bb.y) + (bb.z + bb.w));
            *(LAS f32x4*)(KKN + o) = -kk; *(LAS f32x4*)(BV + o) = kk * a; *(LAS f32x4*)(Kx + o) = km;
            if ((tid & 15) == 0) BON[tokC] = bon;
        }
        __syncthreads();
#ifdef ISSUE_LATE
        if (t0 + ntok < TT) RW_ISSUE(t0 + ntok, RW_CH);
#endif
        if (tid < 256) {
#ifndef SCAN_UNROLL
#define SCAN_UNROLL 2
#endif
#pragma unroll SCAN_UNROLL
            for (int i = 0; i < ntok; ++i) {
                const int o = i * 64 + kq * 8;
                const f32x4 n0 = *(const LAS f32x4*)(KKN + o), n1 = *(const LAS f32x4*)(KKN + o + 4);
                const f32x4 w0 = *(const LAS f32x4*)(W + o), w1 = *(const LAS f32x4*)(W + o + 4);
                const f32x4 b0 = *(const LAS f32x4*)(BV + o), b1 = *(const LAS f32x4*)(BV + o + 4);
                const f32x4 k0 = *(const LAS f32x4*)(Kx + o), k1 = *(const LAS f32x4*)(Kx + o + 4);
                const f32x4 r0 = *(const LAS f32x4*)(R + o), r1 = *(const LAS f32x4*)(R + o + 4);
                const f32x2 vpair = *(const LAS f32x2*)(V + i * 64 + 2 * vrow);
                const f32x2 nn[4] = {{n0.x, n0.y}, {n0.z, n0.w}, {n1.x, n1.y}, {n1.z, n1.w}};
                const f32x2 ww[4] = {{w0.x, w0.y}, {w0.z, w0.w}, {w1.x, w1.y}, {w1.z, w1.w}};
                const f32x2 bb[4] = {{b0.x, b0.y}, {b0.z, b0.w}, {b1.x, b1.y}, {b1.z, b1.w}};
                const f32x2 kk2[4] = {{k0.x, k0.y}, {k0.z, k0.w}, {k1.x, k1.y}, {k1.z, k1.w}};
                const f32x2 rr2[4] = {{r0.x, r0.y}, {r0.z, r0.w}, {r1.x, r1.y}, {r1.z, r1.w}};
                float sa[2], yy[2];
#pragma unroll
                for (int q = 0; q < 2; ++q) {
                    f32x2 s2 = S[q][0] * nn[0];
                    s2 = __builtin_elementwise_fma(S[q][1], nn[1], s2);
                    f32x2 s3 = S[q][2] * nn[2];
                    s3 = __builtin_elementwise_fma(S[q][3], nn[3], s3);
                    s2 = s2 + s3;
                    sa[q] = s2.x + s2.y;
                }
                sa[0] += dppf<0xB1>(sa[0]); sa[1] += dppf<0xB1>(sa[1]);
                sa[0] += dppf<0x4E>(sa[0]); sa[1] += dppf<0x4E>(sa[1]);
                sa[0] += dppf<0x141>(sa[0]); sa[1] += dppf<0x141>(sa[1]);
#pragma unroll
                for (int q = 0; q < 2; ++q) {
                    const f32x2 sa2 = {sa[q], sa[q]}, vv2 = {vpair[q], vpair[q]};
#pragma unroll
                    for (int j = 0; j < 4; ++j) S[q][j] = __builtin_elementwise_fma(S[q][j], ww[j], __builtin_elementwise_fma(sa2, bb[j], vv2 * kk2[j]));
                    f32x2 y2 = S[q][0] * rr2[0];
                    y2 = __builtin_elementwise_fma(S[q][1], rr2[1], y2);
                    f32x2 y3 = S[q][2] * rr2[2];
                    y3 = __builtin_elementwise_fma(S[q][3], rr2[3], y3);
                    y2 = y2 + y3;
                    yy[q] = y2.x + y2.y;
                }
                yy[0] += dppf<0xB1>(yy[0]); yy[1] += dppf<0xB1>(yy[1]);
                yy[0] += dppf<0x4E>(yy[0]); yy[1] += dppf<0x4E>(yy[1]);
                yy[0] += dppf<0x141>(yy[0]); yy[1] += dppf<0x141>(yy[1]);
                if (kq == 0) *(LAS f32x2*)(Y + i * 64 + 2 * vrow) = (f32x2){yy[0], yy[1]};
            }
        }
        __syncthreads();
        if (tokC < ntok && (t0 > 0 || b == 0)) {
            const int o = tokC * 64 + ch4;
            const f32x4 y = *(const LAS f32x4*)(Y + o);
            const float mean = sum16((y.x + y.y) + (y.z + y.w)) * (1.f / 64.f);
            const f32x4 d = y - mean;
            const float var = sum16((d.x * d.x + d.y * d.y) + (d.z * d.z + d.w * d.w)) * (1.f / 64.f);
            const float rs = 1.f / sqrtf(var + 6.4e-4f);
            f32x4 yn = d * rs * lgv + lbv;
            const f32x4 vv = *(const LAS f32x4*)(V + o), gg = *(const LAS f32x4*)(G + o);
            yn = (yn + BON[tokC] * vv) * gg;
            u32x2 w; w.x = pk2(yn.x, yn.y); w.y = pk2(yn.z, yn.w);
            *(u32x2*)(Yo + (size_t)tokrow(b, t0 + tokC) * DM + cC) = w;
        } else if (tokC < ntok) {
        }
        __syncthreads();
        t0 += ntok;
    }
}

constexpr int SB_KS = 0, SB_VT = 9216, SB_Q = 18432;
#ifndef SB_THR_VAL
#define SB_THR_VAL 90.f
#endif
constexpr float SB_THR = SB_THR_VAL;

__device__ __forceinline__ void sb_unit(const Params& p, int l, int b, int h, int qb, LAS unsigned char* lds, int tid) {
    const int wave = tid >> 6, lane = tid & 63, ql = lane & 15, g = lane >> 4;
    const bf16* P = (const bf16*)(p.ws + WS_RB);
    bf16* Yo = (bf16*)(p.ws + WS_RA);
    LAS bf16* Ks = (LAS bf16*)(lds + SB_KS); LAS bf16* Vt = (LAS bf16*)(lds + SB_VT);
    const int tq = (qb < 0 ? 0 : NMETA + 128 * qb) + 16 * wave + ql;
    const bool wave_valid = (qb >= 0) || (wave == 0);
    const int tqc = wave_valid ? tq : 0;
    bf16x8 qF[2];
    {
        const bf16* qp = P + (size_t)tokrow(b, tqc) * INC + C_Q + h * 64 + 8 * g;
        qF[0] = ldnt<bf16x8>(qp); qF[1] = ldnt<bf16x8>(qp + 32);
    }
    unsigned P01, P23; const unsigned ONES = 0x3F803F80u;
    { const unsigned p0 = (4 * g + 0 > ql) ? 0x3F80u : 0u, p1 = (4 * g + 1 > ql) ? 0x3F80u : 0u, p2 = (4 * g + 2 > ql) ? 0x3F80u : 0u, p3 = (4 * g + 3 > ql) ? 0x3F80u : 0u;
      P01 = p0 | (p1 << 16); P23 = p2 | (p3 << 16); }
    const bf16x8 FA = __builtin_bit_cast(bf16x8, (u32x4){P01, P23, ONES, ONES});
    const bf16x8 FB = __builtin_bit_cast(bf16x8, (u32x4){0u, 0u, P01, P23});
    const bf16x8 F1 = __builtin_bit_cast(bf16x8, (u32x4){ONES, ONES, ONES, ONES});
    f32x4 O[4];
#pragma unroll
    for (int d = 0; d < 4; ++d) O[d] = (f32x4){0.f, 0.f, 0.f, 0.f};
    float carry = 0.f;
    const int wave_tq_max = (qb < 0 ? 0 : NMETA + 128 * qb) + 16 * wave + 15;
    const int i_hi = qb < 0 ? 0 : 2 * qb + 2;
    const int kap = tid >> 3, piece = tid & 7;
    const int slot = (kap >> 5) * 32 + ((kap >> 2) & 3) * 8 + ((kap >> 4) & 1) * 4 + (kap & 3);
    bool wave_done = !wave_valid;
    volatile LAS unsigned* orw = (volatile LAS unsigned*)(lds + SB_Q + 16);
    if (tid < 2) orw[tid] = 0u;
    int nit = 0;
    for (int it = i_hi; it >= 0; --it, ++nit) {
        const int tk0 = NMETA + 64 * (it - 1);
        {
            const int tk = tk0 + kap;
            u32x4 kv = {0u, 0u, 0u, 0u}, vv = kv;
            if (tk >= 0) { const bf16* rp = P + (size_t)tokrow(b, tk) * INC + h * 64 + piece * 8; kv = ldnt<u32x4>(rp + C_SK); vv = ldnt<u32x4>(rp + C_SV); }
            *(LAS u32x4*)(Ks + kap * 72 + piece * 8) = kv;
            const unsigned vu[4] = {vv.x, vv.y, vv.z, vv.w};
#pragma unroll
            for (int e = 0; e < 4; ++e) { Vt[(piece * 8 + 2 * e) * 72 + slot] = (bf16)(vu[e] & 0xffffu); Vt[(piece * 8 + 2 * e + 1) * 72 + slot] = (bf16)(vu[e] >> 16); }
        }
        __syncthreads();
        if (!wave_done && tk0 < wave_tq_max) {
            f32x4 s[4];
#pragma unroll
            for (int m = 0; m < 4; ++m) {
                s[m] = (f32x4){0.f, 0.f, 0.f, 0.f};
#pragma unroll
                for (int ks = 0; ks < 2; ++ks) {
                    bf16x8 a = *(const LAS bf16x8*)(Ks + (16 * m + ql) * 72 + 32 * ks + 8 * g);
                    s[m] = __builtin_amdgcn_mfma_f32_16x16x32_bf16(a, qF[ks], s[m], 0, 0, 0);
                }
            }
            float z[4][4], sp[4][4]; bool val[4][4];
            unsigned hi[4][2], lo[4][2];
#pragma unroll
            for (int m = 0; m < 4; ++m) {
#pragma unroll
                for (int r = 0; r < 4; ++r) {
                    const int tk = tk0 + 16 * m + 4 * g + r;
                    val[m][r] = (tk >= 0) && (tk < tq);
                    z[m][r] = s[m][r] * 0.125f;
                    sp[m][r] = val[m][r] ? softplusf(z[m][r]) : 0.f;
                }
#pragma unroll
                for (int r2 = 0; r2 < 2; ++r2) {
                    const unsigned hh = pk2(sp[m][2 * r2], sp[m][2 * r2 + 1]);
                    hi[m][r2] = hh;
                    lo[m][r2] = pk2(sp[m][2 * r2] - bflo(hh), sp[m][2 * r2 + 1] - bfhi(hh));
                }
            }
            const bf16x8 hF0 = __builtin_bit_cast(bf16x8, (u32x4){hi[0][0], hi[0][1], hi[1][0], hi[1][1]});
            const bf16x8 hF1 = __builtin_bit_cast(bf16x8, (u32x4){hi[2][0], hi[2][1], hi[3][0], hi[3][1]});
            const bf16x8 lF0 = __builtin_bit_cast(bf16x8, (u32x4){lo[0][0], lo[0][1], lo[1][0], lo[1][1]});
            const bf16x8 lF1 = __builtin_bit_cast(bf16x8, (u32x4){lo[2][0], lo[2][1], lo[3][0], lo[3][1]});
            f32x4 cum[4];
            const f32x4 zero4 = {0.f, 0.f, 0.f, 0.f};
            cum[0] = __builtin_amdgcn_mfma_f32_16x16x32_bf16(FA, hF0, zero4, 0, 0, 0);
            cum[0] = __builtin_amdgcn_mfma_f32_16x16x32_bf16(FA, lF0, cum[0], 0, 0, 0);
            cum[0] = __builtin_amdgcn_mfma_f32_16x16x32_bf16(F1, hF1, cum[0], 0, 0, 0);
            cum[0] = __builtin_amdgcn_mfma_f32_16x16x32_bf16(F1, lF1, cum[0], 0, 0, 0);
            cum[1] = __builtin_amdgcn_mfma_f32_16x16x32_bf16(FB, hF0, zero4, 0, 0, 0);
            cum[1] = __builtin_amdgcn_mfma_f32_16x16x32_bf16(FB, lF0, cum[1], 0, 0, 0);
            cum[1] = __builtin_amdgcn_mfma_f32_16x16x32_bf16(F1, hF1, cum[1], 0, 0, 0);
            cum[1] = __builtin_amdgcn_mfma_f32_16x16x32_bf16(F1, lF1, cum[1], 0, 0, 0);
            cum[2] = __builtin_amdgcn_mfma_f32_16x16x32_bf16(FA, hF1, zero4, 0, 0, 0);
            cum[2] = __builtin_amdgcn_mfma_f32_16x16x32_bf16(FA, lF1, cum[2], 0, 0, 0);
            cum[3] = __builtin_amdgcn_mfma_f32_16x16x32_bf16(FB, hF1, zero4, 0, 0, 0);
            cum[3] = __builtin_amdgcn_mfma_f32_16x16x32_bf16(FB, lF1, cum[3], 0, 0, 0);
            unsigned af[4][2];
#pragma unroll
            for (int m = 0; m < 4; ++m) {
                float av[4];
#pragma unroll
                for (int r = 0; r < 4; ++r) { const float la = (z[m][r] - sp[m][r]) - cum[m][r] - carry; av[r] = val[m][r] ? fast_exp(la) : 0.f; }
                af[m][0] = pk2(av[0], av[1]); af[m][1] = pk2(av[2], av[3]);
            }
            const bf16x8 aF0 = __builtin_bit_cast(bf16x8, (u32x4){af[0][0], af[0][1], af[1][0], af[1][1]});
            const bf16x8 aF1 = __builtin_bit_cast(bf16x8, (u32x4){af[2][0], af[2][1], af[3][0], af[3][1]});
            const float tot = __shfl(cum[0][0] + sp[0][0], ql);
            carry += tot;
#pragma unroll
            for (int d = 0; d < 4; ++d) {
                bf16x8 v0 = *(const LAS bf16x8*)(Vt + (16 * d + ql) * 72 + 8 * g);
                bf16x8 v1 = *(const LAS bf16x8*)(Vt + (16 * d + ql) * 72 + 32 + 8 * g);
                O[d] = __builtin_amdgcn_mfma_f32_16x16x32_bf16(v0, aF0, O[d], 0, 0, 0);
                O[d] = __builtin_amdgcn_mfma_f32_16x16x32_bf16(v1, aF1, O[d], 0, 0, 0);
            }
            if (__all(carry > SB_THR)) wave_done = true;
        }
        if (lane == 0 && !wave_done && it > 0) orw[nit & 1] = 1u;
        __syncthreads();
        const unsigned more = orw[nit & 1];
        if (tid == 0) orw[(nit + 1) & 1] = 0u;
        if (!more) break;
    }
    if (wave_valid && (qb >= 0 || b == 0)) {
        float ss = 0.f;
#pragma unroll
        for (int d = 0; d < 4; ++d) ss += (O[d].x * O[d].x + O[d].y * O[d].y) + (O[d].z * O[d].z + O[d].w * O[d].w);
        ss += __shfl_xor(ss, 16); ss += __shfl_xor(ss, 32);
        const float inv = 1.f / sqrtf(ss * (1.f / 64.f) + 1e-6f);
        bf16* yp = Yo + (size_t)tokrow(b, tq) * DM + 512 + h * 64;
        const float* gp = p.sb_gain + l * 512 + h * 64;
#pragma unroll
        for (int d = 0; d < 4; ++d) {
            const f32x4 gg = *(const f32x4*)(gp + 16 * d + 4 * g);
            const f32x4 v = O[d] * inv * gg;
            u32x2 w; w.x = pk2(v.x, v.y); w.y = pk2(v.z, v.w);
            *(u32x2*)(yp + 16 * d + 4 * g) = w;
        }
    }
}

__device__ __forceinline__ void mix_phase(const Params& p_in, int l, LAS unsigned char* lds, int cslot = -1) {
#if defined(__HIP_DEVICE_COMPILE__)
    const Params p = *kargs();
#else
    const Params& p = p_in;
#endif
    const int tid = ltid();
    const int G = gridDim.x;
#ifdef CHAINS_HIGH
    for (int c = (int)blockIdx.x - (G - NB * 8); c < NB * 8; c += G) if (c >= 0) rwkv_chain(
#else
    for (int c = blockIdx.x; c < NB * 8; c += G) rwkv_chain(
#endif
    p, l, c >> 3, c & 7, lds, tid);
    unsigned* ctr = (unsigned*)(p.ws + WS_CTL) + 64 * (cslot < 0 ? l + 1 : cslot);
    volatile LAS unsigned* qw = (volatile LAS unsigned*)(lds + SB_Q);
    for (;;) {
        __syncthreads();
        if (tid == 0) qw[0] = atomicAdd(ctr, 1u);
        __syncthreads();
        const unsigned u = qw[0];
        if (u >= 2048u + 8u) break;
        if (u < 2048u) { const int qb = 15 - (int)(u >> 7), bh = (int)(u & 127u); sb_unit(p, l, bh >> 3, bh & 7, qb, lds, tid); }
        else sb_unit(p, l, 0, (int)(u - 2048u), -1, lds, tid);
    }
    if (l == 0 && (int)blockIdx.x >= NB * 8) {
        __syncthreads();
        conv_phase(p, lds, 1, NL, (int)blockIdx.x - NB * 8, G - NB * 8);
    }
}


#ifdef DIAG_W
__device__ __forceinline__ bool check_win(const Params& p) {
    const int t = ltid(), xl = blockIdx.x >> 3, nxl = gridDim.x >> 3;
    bool bad = false;
    for (int l = 0; l < NL; ++l) {
        const float* W = p.w_in + (size_t)l * DM * INC; const bf16* WT = (const bf16*)(p.ws + WS_WIN + l * SZ_WIN);
        for (int g = xl * NTHR + t; g < INC * (DM / 8); g += nxl * NTHR) {
            const int n = g / (DM / 8), k0 = (g % (DM / 8)) * 8;
            const u32x4 v = *(const u32x4*)(WT + (size_t)n * DM + k0);
            const unsigned vv[4] = {v.x, v.y, v.z, v.w};
#pragma unroll
            for (int j = 0; j < 4; ++j) { const unsigned e = pk2(W[(size_t)(k0 + 2 * j) * INC + n], W[(size_t)(k0 + 2 * j + 1) * INC + n]); bad |= (e != vv[j]); }
        }
    }
    return __any(bad);
}
#endif

#define XB_TMO      128
#define XB_XCNT(j)  (256  + 64 * (j))
#define XB_XSUB(j)  (1280 + 64 * (j))
#define XB_XGEN(j)  (2304 + 64 * (j))
#define XB_TOP      3328
#define XB_TOPGEN   3392
#define XCD_BAR_WORDS 3456
#define XB_SPIN_CAP (1u << 18)

__device__ __forceinline__ unsigned xb_ld(unsigned* p)              { return __hip_atomic_load(p, __ATOMIC_RELAXED, __HIP_MEMORY_SCOPE_AGENT); }
__device__ __forceinline__ unsigned xb_add(unsigned* p, unsigned v) { return __hip_atomic_fetch_add(p, v, __ATOMIC_RELAXED, __HIP_MEMORY_SCOPE_AGENT); }
__device__ __forceinline__ unsigned xb_xcc_id() { return (unsigned)__builtin_amdgcn_s_getreg((3 << 11) | 20) & 0xFu; }
#define XB_SPIN(cond, bar) do { unsigned _sp = 0; while (cond) { __builtin_amdgcn_s_sleep(1); \
    if ((++_sp & 255u) == 0u) { if (xb_ld(&(bar)[XB_TMO])) break; if (_sp > XB_SPIN_CAP) { atomicAdd(&(bar)[XB_TMO], 1u); break; } } } } while (0)

struct XcdBarrier {
    unsigned* bar; unsigned x;
    volatile LAS unsigned* st;
};

__device__ __forceinline__ XcdBarrier xcd_barrier_post(unsigned* bar, volatile LAS unsigned* st) {
    XcdBarrier b; b.bar = bar; b.x = xb_xcc_id(); b.st = st;
    if (threadIdx.x == 0) (void)xb_add(&bar[XB_XCNT(b.x)], 1u);
    return b;
}
__device__ __forceinline__ void xcd_barrier_complete(unsigned* bar, unsigned x, unsigned& nloc, unsigned& nx) {
    const unsigned G = gridDim.x * gridDim.y * gridDim.z;
    unsigned sum, cnt, mine, sp = 0u;
    for (;;) {
        sum = 0u; cnt = 0u; mine = 0u;
#pragma unroll
        for (unsigned j = 0; j < 16; ++j) { const unsigned c = xb_ld(&bar[XB_XCNT(j)]); sum += c; cnt += (c > 0u) ? 1u : 0u; mine = (j == x) ? c : mine; }
        if (sum == G) break;
        __builtin_amdgcn_s_sleep(1);
        if ((++sp & 255u) == 0u) { if (xb_ld(&bar[XB_TMO])) break; if (sp > XB_SPIN_CAP) { atomicAdd(&bar[XB_TMO], 1u); break; } }
    }
    nloc = mine > 0u ? mine : 1u; nx = cnt > 0u ? cnt : 1u;
}

__device__ __forceinline__ void xcd_barrier(const XcdBarrier& b) {
    asm volatile("s_waitcnt vmcnt(0)" ::: "memory");
    __syncthreads();
    if (threadIdx.x == 0) {
        unsigned* bar = b.bar;
        __builtin_amdgcn_s_waitcnt(0);
        unsigned nloc = b.st[0], nx = b.st[1];
        if (nloc == 0u) { xcd_barrier_complete(bar, b.x, nloc, nx); b.st[0] = nloc; b.st[1] = nx; }
        const unsigned old = xb_add(&bar[XB_XSUB(b.x)], 1u);
        const unsigned gen = old / nloc;
        if (old + 1u == (gen + 1u) * nloc) {
            __builtin_amdgcn_fence(__ATOMIC_RELEASE, "agent");
            asm volatile("s_waitcnt vmcnt(0)" ::: "memory");
            const unsigned og = xb_add(&bar[XB_TOP], 1u);
            const unsigned tg = og / nx;
            if (og + 1u == (tg + 1u) * nx) xb_add(&bar[XB_TOPGEN], 1u);
            else XB_SPIN(xb_ld(&bar[XB_TOPGEN]) == tg, bar);
            __builtin_amdgcn_fence(__ATOMIC_ACQUIRE, "agent");
            xb_add(&bar[XB_XGEN(b.x)], 1u);
            asm volatile("s_waitcnt vmcnt(0)" ::: "memory");
        } else {
            XB_SPIN(xb_ld(&bar[XB_XGEN(b.x)]) == gen, bar);
            __builtin_amdgcn_fence(__ATOMIC_ACQUIRE, "agent");
            asm volatile("s_waitcnt vmcnt(0)" ::: "memory");
        }
    }
    __syncthreads();
}

template <int N, int K, int ACT>
__device__ __forceinline__ void gemm_call(const bf16* A, const bf16* Bt, bf16* O, LAS unsigned char* lds) {
    pg8::Gemm gm{A, Bt, MR, N, K};
    pg8::StaticOrder S; S.init(MR, N, gridDim.x, blockIdx.x);
    EpiOut E{O, N, ACT};
    pg8::gemm_phase<EpiOut, pg8::StaticOrder, true, true>(lds, gm, S, E);
    meta_gemm(A, Bt, N, K, O, ACT, lds, ltid());
}

template <int K>
__device__ __forceinline__ void gemm_call_f32(const bf16* A, const bf16* Bt, float* lo, float* hi, LAS unsigned char* lds) {
    pg8::Gemm gm{A, Bt, MR, DM, K};
    pg8::StaticOrder S; S.init(MR, DM, gridDim.x, blockIdx.x);
    EpiF32Split E{lo, hi};
    pg8::gemm_phase<EpiF32Split, pg8::StaticOrder, true, true>(lds, gm, S, E);
    meta_gemm(A, Bt, DM, K, nullptr, 0, lds, ltid(), lo, hi);
}

__global__ void __launch_bounds__(NTHR, 2) trunk_fwd(Params p_unused) {
#if defined(__HIP_DEVICE_COMPILE__)
#define KP (kargs())
    extern __shared__ __attribute__((aligned(16))) unsigned char shm[];
    LAS unsigned char* lds = (LAS unsigned char*)shm;
    cg::grid_group grid = cg::this_grid();
#ifndef POST_SLEEP
#define POST_SLEEP 0
#endif
#ifdef USE_XCD_BARRIER
    volatile LAS unsigned* bst = (volatile LAS unsigned*)(lds + 131072 + 64);
    if (threadIdx.x < 2) bst[threadIdx.x] = 0u;
    __syncthreads();
    (void)xcd_barrier_post((unsigned*)(KP->ws + WS_BAR), bst);
    grid.sync();
#define GSYNC() do { XcdBarrier xb_; xb_.bar = (unsigned*)(KP->ws + WS_BAR); xb_.x = xb_xcc_id(); xb_.st = (volatile LAS unsigned*)(lds + 131072 + 64); xcd_barrier(xb_); } while (0)
#else
#define GSYNC() do { asm volatile("s_waitcnt vmcnt(0)" ::: "memory"); __threadfence(); asm volatile("s_waitcnt vmcnt(0)" ::: "memory"); grid.sync(); __threadfence(); for (int s_ = 0; s_ < POST_SLEEP; ++s_) __builtin_amdgcn_s_sleep(127); } while (0)
#endif
#define RA ((bf16*)(KP->ws + WS_RA))
#define RB ((bf16*)(KP->ws + WS_RB))
#define HM ((float*)(KP->ws + WS_HM))
    { unsigned* ctl0 = (unsigned*)(KP->ws + WS_CTL); if (blockIdx.x == 0 && threadIdx.x < 8) ctl0[64 * threadIdx.x] = 0u; }
    { const Params pc_ = *KP; conv_phase(pc_, lds, 0, gridDim.x > NB * 8 ? 1 : NL, blockIdx.x, gridDim.x); }
    norm_phase(nullptr, nullptr, nullptr, KP->x, KP->meta, KP->out, HM, KP->g_pre_mix, RA);
    GSYNC();
#ifdef DIAG_W
    const bool wbad = check_win(p);
#endif
    for (int l = 0; l < NL; ++l) {
        for (int gi = 0; gi < 4; ++gi) {
            if (gi == 1) {
                #ifdef PROBE_MIX2
                for (int rep = 0; rep < 2; ++rep) { if (rep) GSYNC(); const Params pm_ = *KP; mix_phase(pm_, l, lds, rep ? (l == 0 ? 0 : 4 + l) : -1); }
#else
                { const Params pm_ = *KP; mix_phase(pm_, l, lds); }
#endif
                GSYNC();
            }
            if (gi == 0) gemm_call<INC, DM, 0>(RA, (const bf16*)(KP->ws + WS_WIN + l * SZ_WIN), RB, lds);
            else if (gi == 1) gemm_call_f32<DM>(RA, (const bf16*)(KP->ws + WS_WOUT + l * SZ_WOUT), (float*)RB, (float*)RB + (size_t)MT * 512, lds);
            else if (gi == 2) gemm_call<DFF, DM, 1>(RA, (const bf16*)(KP->ws + WS_WUP + l * SZ_WUP), RB, lds);
            else gemm_call_f32<DFF>(RB, (const bf16*)(KP->ws + WS_WDN + l * SZ_WDN), (float*)RA, (float*)(KP->ws + WS_T2HI), lds);
            GSYNC();
            if (gi == 1) {
                norm_phase((const float*)RB, (const float*)RB + (size_t)MT * 512, KP->g_post_mix + l * DM, l == 0 ? KP->x : KP->out, l == 0 ? KP->meta : HM, KP->out, HM, KP->g_pre_ffn + l * DM, RA);
                GSYNC();
            } else if (gi == 3) {
                norm_phase((const float*)RA, (const float*)(KP->ws + WS_T2HI), KP->g_post_ffn + l * DM, KP->out, HM, KP->out, HM, l + 1 < NL ? KP->g_pre_mix + (l + 1) * DM : nullptr, RA);
                if (l + 1 < NL) GSYNC();
            }
        }
    }
#ifdef DIAG_W
    GSYNC();
    if (wbad && threadIdx.x == 0) KP->out[blockIdx.x] += 100000.f;
#endif
#undef RA
#undef RB
#undef HM
#endif
}

extern "C" void kernel_launch(void* const* d_in, const int* in_sizes, int n_in, void* d_out, int out_size, void* d_ws, size_t ws_size, hipStream_t stream) {
    static int grid = 0;
    if (grid == 0) {
        if (n_in != 22 || ws_size < WS_END) { fprintf(stderr, "kernel_launch: unexpected n_in %d / ws_size %zu (need %zu)\n", n_in, ws_size, (size_t)WS_END); grid = -1; return; }
        int dev = 0, cus = 0, per_cu = 0;
        hipGetDevice(&dev);
        hipDeviceGetAttribute(&cus, hipDeviceAttributeMultiprocessorCount, dev);
        if (hipFuncSetAttribute((const void*)trunk_fwd, hipFuncAttributeMaxDynamicSharedMemorySize, LDS_BYTES) != hipSuccess) { fprintf(stderr, "kernel_launch: hipFuncSetAttribute failed\n"); grid = -1; return; }
        if (hipOccupancyMaxActiveBlocksPerMultiprocessor(&per_cu, (const void*)trunk_fwd, NTHR, LDS_BYTES) != hipSuccess || per_cu < 1) { fprintf(stderr, "kernel_launch: occupancy query says %d\n", per_cu); per_cu = 1; }
        (void)hipGetLastError();
        grid = cus * per_cu;
        fprintf(stderr, "kernel_launch: grid %d (cus %d x %d)\n", grid, cus, per_cu);
    }
    if (grid < 0) return;
    if (hipMemsetAsync((char*)d_ws + WS_CTL, 0, WS_HM, stream) != hipSuccess) { fprintf(stderr, "kernel_launch: memset failed\n"); return; }
    Params p{};
    const float** f = (const float**)&p;
    for (int i = 0; i < 22; ++i) f[i] = (const float*)d_in[i];
    p.out = (float*)d_out; p.ws = (unsigned char*)d_ws;
    void* args[] = {&p};
    hipError_t e = hipLaunchCooperativeKernel((const void*)trunk_fwd, dim3(grid), dim3(NTHR), args, LDS_BYTES, stream);
    if (e != hipSuccess) fprintf(stderr, "cooperative launch failed: %s (grid %d)\n", hipGetErrorString(e), grid);
}
```

```cpp
#define SCAN_UNROLL 2
#define USE_XCD_BARRIER 1
#include <hip/hip_runtime.h>
#include <hip/hip_cooperative_groups.h>
#include <cstdio>
#include <cstdint>
namespace cg = cooperative_groups;
namespace pg8 {
#define PG8_LAS __attribute__((address_space(3)))
#ifndef PG8_AUX
#define PG8_AUX 2
#endif
typedef unsigned short bf16_t;
typedef short bf16x8 __attribute__((ext_vector_type(8)));
typedef float f32x4 __attribute__((ext_vector_type(4)));
typedef unsigned u32x4 __attribute__((ext_vector_type(4)));
constexpr int BM = 256, BK = 64, HALF = 128, HTB = HALF * BK * 2  , STAGE_BYTES = 8 * HTB, NXCD = 8, WGM = 8;

__host__ __device__ __forceinline__ int lds_byte(int r, int c) { const int st = (r >> 4) * 2 + (c >> 5), rr = r & 15, cc = c & 31, ob = rr * 64 + cc * 2; return st * 1024 + (ob ^ (((ob >> 9) & 1) << 5)); }
__host__ __device__ __forceinline__ void stage_rc(int b, int& R, int& C) { const int st = b / 1024, sb = b % 1024, swz = sb ^ (((sb >> 9) & 1) << 5); R = (st >> 1) * 16 + swz / 64; C = (st & 1) * 32 + (swz % 64) / 2; }
__host__ __device__ __forceinline__ int perm32(int rho) { const int n = rho >> 4, i = rho & 15; return 8 * (i >> 2) + 4 * n + (i & 3); }

struct Unit { int pm, pn; };
struct Gemm { const bf16_t* A; const bf16_t* Bt; int M, N, K; };

struct StaticOrder {
    int nM, nN, nwg, G, c;
    __host__ __device__ void init(int M, int N, int G_, int c_) { nM = M / BM; nN = N / BM; nwg = nM * nN; G = G_; c = c_; }
    __host__ __device__ bool next(int i, Unit& u) const {
        const long L = (long)i * G + c; if (L >= nwg) return false;
        int wgid = (int)L; { const int q = nwg / NXCD, r = nwg % NXCD, xcd = wgid % NXCD, off = wgid / NXCD; wgid = (xcd < r ? xcd * (q + 1) : r * (q + 1) + (xcd - r) * q) + off; }
        const int nig = WGM * nN, gid = wgid / nig, fm = gid * WGM, gsz = (nM - fm) < WGM ? (nM - fm) : WGM;
        u.pm = fm + ((wgid % nig) % gsz); u.pn = (wgid % nig) / gsz; return true;
    }
    __device__ __forceinline__ void a_ready(const Unit&) const {}
    __device__ __forceinline__ void done(const Unit&) const {}
};

__device__ __forceinline__ unsigned cvt_pk_bf16(float lo, float hi) { unsigned r; asm volatile("v_cvt_pk_bf16_f32 %0, %1, %2" : "=v"(r) : "v"(lo), "v"(hi)); return r; }
typedef float f32x2 __attribute__((ext_vector_type(2)));
template <class Epi, class Sched, bool ALIGN_EPI = false, bool SP2 = false>
__device__ __forceinline__ void gemm_phase(PG8_LAS unsigned char* lds, const Gemm g, const Sched& S, const Epi& E) {
    int tid_ = threadIdx.x; asm volatile("" : "+v"(tid_));
    const int tid = tid_, wid = __builtin_amdgcn_readfirstlane(tid >> 6), lane = tid & 63, wr = wid >> 2, wc = wid & 3, fr = lane & 15, fq = lane >> 4;
    const int K = g.K, nt = K / BK;
    unsigned voffA[2], voffB[2];
#pragma unroll
    for (int i = 0; i < 2; ++i) { int R, C; stage_rc(tid * 16 + i * 8192, R, C); const int Rb = Epi::PERM ? ((R & ~31) + perm32(R & 31)) : R;
        voffA[i] = (unsigned)(R * K + C) * 2u; voffB[i] = (unsigned)(Rb * K + C) * 2u; }
    const size_t kstep = (size_t)(BK * 2);
    const size_t hstep = (size_t)HALF * K * 2;
    const size_t tstep = 2 * hstep;
    const unsigned ldsw = (unsigned)wid * 1024u;
    const int aoff = lds_byte(wr * 64 + fr, fq * 8), boff = lds_byte(wc * 32 + fr, fq * 8);
#define PG8_SA(b, h) (((b) * 2 + (h)) * HTB)
#define PG8_SB(b, h) ((4 + (b) * 2 + (h)) * HTB)
#define PG8_STAGE(bufoff, gbase, voff) do { _Pragma("unroll") for (int _i = 0; _i < 2; ++_i) \
        __builtin_amdgcn_global_load_lds((const unsigned*)((const char*)(gbase) + (voff)[_i]), (PG8_LAS unsigned*)(lds + (bufoff) + ldsw + _i * 8192), 16, 0, 0); } while (0)
#define PG8_LDA(dst, b, h) do { _Pragma("unroll") for (int m = 0; m < 4; ++m) _Pragma("unroll") for (int k = 0; k < 2; ++k) dst[m][k] = *(const PG8_LAS bf16x8*)(lds + PG8_SA(b, h) + aoff + m * 2048 + k * 1024); } while (0)
#define PG8_LDB(dst, b, h) do { _Pragma("unroll") for (int n = 0; n < 2; ++n) _Pragma("unroll") for (int k = 0; k < 2; ++k) dst[n][k] = *(const PG8_LAS bf16x8*)(lds + PG8_SB(b, h) + boff + n * 2048 + k * 1024); } while (0)
#define PG8_MMA(ai, bj, At, Bt) do { __builtin_amdgcn_s_setprio(1); _Pragma("unroll") for (int m = 0; m < 4; ++m) _Pragma("unroll") for (int n = 0; n < 2; ++n) _Pragma("unroll") for (int k = 0; k < 2; ++k) \
        acc[ai][bj][m][n] = __builtin_amdgcn_mfma_f32_16x16x32_bf16(Bt[n][k], At[m][k], acc[ai][bj][m][n], 0, 0, 0); __builtin_amdgcn_s_setprio(0); } while (0)
#define PG8_WAIT_V(n) asm volatile("s_waitcnt vmcnt(" #n ")" ::: "memory")
#define PG8_WAIT_L(n) asm volatile("s_waitcnt lgkmcnt(" #n ")" ::: "memory")
#define PG8_BAR __builtin_amdgcn_s_barrier()
#define PG8_SCHED __builtin_amdgcn_sched_barrier(0)
    Unit cur, nxt; int ui = 0;
    if (!S.next(0, cur)) return;
    f32x4 acc[2][2][4][2];
#pragma unroll
    for (int a = 0; a < 2; ++a)
#pragma unroll
        for (int b = 0; b < 2; ++b)
#pragma unroll
            for (int m = 0; m < 4; ++m)
#pragma unroll
                for (int n = 0; n < 2; ++n) acc[a][b][m][n] = (f32x4){0.f, 0.f, 0.f, 0.f};
    bf16x8 At[4][2], B0[2][2], B1[2][2];
    const char* cA = (const char*)g.A + (size_t)cur.pm * tstep; const char* cB = (const char*)g.Bt + (size_t)cur.pn * tstep;
    S.a_ready(cur);
    if constexpr (SP2) {
        PG8_STAGE(PG8_SB(0, 0), cB, voffB); PG8_STAGE(PG8_SB(0, 1), cB + hstep, voffB); PG8_STAGE(PG8_SA(0, 0), cA, voffA); PG8_STAGE(PG8_SA(0, 1), cA + hstep, voffA);
        if (wr == 1) PG8_BAR;
        PG8_WAIT_V(2); PG8_BAR;
        PG8_STAGE(PG8_SB(1, 0), cB + kstep, voffB); PG8_STAGE(PG8_SA(1, 0), cA + kstep, voffA); PG8_STAGE(PG8_SB(1, 1), cB + hstep + kstep, voffB);
        PG8_WAIT_V(6); PG8_BAR;
    } else {
        PG8_STAGE(PG8_SB(0, 0), cB, voffB); PG8_STAGE(PG8_SA(0, 0), cA, voffA); PG8_STAGE(PG8_SB(0, 1), cB + hstep, voffB); PG8_STAGE(PG8_SA(0, 1), cA + hstep, voffA);
        if (wr == 1) PG8_BAR;
        PG8_WAIT_V(4); PG8_BAR;
        PG8_STAGE(PG8_SB(1, 0), cB + kstep, voffB); PG8_STAGE(PG8_SA(1, 0), cA + kstep, voffA); PG8_STAGE(PG8_SB(1, 1), cB + hstep + kstep, voffB);
        PG8_WAIT_V(6); PG8_BAR;
    }
    for (;;) {
        const bool has_next = S.next(ui + 1, nxt);
        const char* nA = has_next ? (const char*)g.A + (size_t)nxt.pm * tstep : cA; const char* nB = has_next ? (const char*)g.Bt + (size_t)nxt.pn * tstep : cB;
        for (int t = 0; t < nt; t += 2) {
            const bool last = (t == nt - 2);
            const char* a1 = cA + (size_t)(t + 1) * kstep;
            const char* a2 = last ? nA : cA + (size_t)(t + 2) * kstep; const char* b2 = last ? nB : cB + (size_t)(t + 2) * kstep;
            const char* a3 = a2 + kstep; const char* b3 = b2 + kstep;
            if (last && has_next) S.a_ready(nxt);
            if constexpr (SP2) {
            PG8_LDB(B0, 0, 0); PG8_LDB(B1, 0, 1); PG8_SCHED; PG8_LDA(At, 0, 0); PG8_STAGE(PG8_SA(1, 1), a1 + hstep, voffA);
            PG8_WAIT_V(8); PG8_WAIT_L(0); PG8_BAR; PG8_MMA(0, 0, At, B0); PG8_MMA(0, 1, At, B1); PG8_BAR; PG8_SCHED;
            PG8_LDA(At, 0, 1); PG8_STAGE(PG8_SB(0, 0), b2, voffB); PG8_STAGE(PG8_SB(0, 1), b2 + hstep, voffB); PG8_STAGE(PG8_SA(0, 0), a2, voffA);
            PG8_WAIT_V(8); PG8_WAIT_L(0); PG8_BAR; PG8_MMA(1, 0, At, B0); PG8_MMA(1, 1, At, B1); PG8_BAR; PG8_SCHED;
            PG8_LDB(B0, 1, 0); PG8_LDB(B1, 1, 1); PG8_SCHED; PG8_LDA(At, 1, 0); PG8_STAGE(PG8_SA(0, 1), a2 + hstep, voffA);
            PG8_WAIT_V(8); PG8_WAIT_L(0); PG8_BAR; PG8_MMA(0, 0, At, B0); PG8_MMA(0, 1, At, B1); PG8_BAR; PG8_SCHED;
            PG8_LDA(At, 1, 1); PG8_STAGE(PG8_SB(1, 0), b3, voffB); PG8_STAGE(PG8_SB(1, 1), b3 + hstep, voffB); PG8_STAGE(PG8_SA(1, 0), a3, voffA);
            PG8_WAIT_V(8); PG8_WAIT_L(0); PG8_BAR; PG8_MMA(1, 0, At, B0); PG8_MMA(1, 1, At, B1); PG8_BAR; PG8_SCHED;
            } else {
            PG8_LDB(B0, 0, 0); PG8_SCHED; PG8_LDA(At, 0, 0); PG8_STAGE(PG8_SA(1, 1), a1 + hstep, voffA);
            PG8_WAIT_L(8); PG8_BAR; PG8_WAIT_L(0); PG8_MMA(0, 0, At, B0); PG8_BAR; PG8_SCHED;
            PG8_LDB(B1, 0, 1); PG8_STAGE(PG8_SB(0, 0), b2, voffB);
            PG8_BAR; PG8_WAIT_L(0); PG8_MMA(0, 1, At, B1); PG8_BAR;
            PG8_LDA(At, 0, 1); PG8_STAGE(PG8_SA(0, 0), a2, voffA);
            PG8_BAR; PG8_WAIT_L(0); PG8_MMA(1, 0, At, B0); PG8_BAR; PG8_SCHED;
            PG8_STAGE(PG8_SB(0, 1), b2 + hstep, voffB);
            PG8_WAIT_V(6); PG8_BAR; PG8_MMA(1, 1, At, B1); PG8_BAR;
            PG8_LDB(B0, 1, 0); PG8_SCHED; PG8_LDA(At, 1, 0); PG8_STAGE(PG8_SA(0, 1), a2 + hstep, voffA);
            PG8_WAIT_L(8); PG8_BAR; PG8_WAIT_L(0); PG8_MMA(0, 0, At, B0); PG8_BAR; PG8_SCHED;
            PG8_LDB(B1, 1, 1); PG8_STAGE(PG8_SB(1, 0), b3, voffB);
            PG8_BAR; PG8_WAIT_L(0); PG8_MMA(0, 1, At, B1); PG8_BAR;
            PG8_LDA(At, 1, 1); PG8_STAGE(PG8_SA(1, 0), a3, voffA);
            PG8_BAR; PG8_WAIT_L(0); PG8_MMA(1, 0, At, B0); PG8_BAR; PG8_SCHED;
            PG8_STAGE(PG8_SB(1, 1), b3 + hstep, voffB);
            PG8_WAIT_V(6); PG8_BAR; PG8_MMA(1, 1, At, B1); PG8_BAR;
            }
        }
        if constexpr (ALIGN_EPI) { if (wr == 0) PG8_BAR; }
        if constexpr (!Epi::AFTER_DRAIN) { E(acc, cur, wr, wc, fr, fq); S.done(cur); }
        if (!has_next) break;
#pragma unroll
        for (int a = 0; a < 2; ++a)
#pragma unroll
            for (int b = 0; b < 2; ++b)
#pragma unroll
                for (int m = 0; m < 4; ++m)
#pragma unroll
                    for (int n = 0; n < 2; ++n) acc[a][b][m][n] = (f32x4){0.f, 0.f, 0.f, 0.f};
        cur = nxt; cA = nA; cB = nB; ++ui;
        if constexpr (ALIGN_EPI) { if (wr == 1) PG8_BAR; }
    }
    PG8_WAIT_V(0);
    if constexpr (!ALIGN_EPI) { if (wr == 0) PG8_BAR; }
    PG8_BAR;
    if constexpr (Epi::AFTER_DRAIN) { E.fused(acc, cur, wr, wc, fr, fq, lds, wid, lane); S.done(cur); }
#undef PG8_SA
#undef PG8_SB
#undef PG8_STAGE
#undef PG8_LDA
#undef PG8_LDB
#undef PG8_MMA
#undef PG8_WAIT_V
#undef PG8_WAIT_L
#undef PG8_BAR
#undef PG8_SCHED
}
}


#define LAS __attribute__((address_space(3)))
typedef unsigned short bf16;
typedef short bf16x8 __attribute__((ext_vector_type(8)));
typedef float f32x4 __attribute__((ext_vector_type(4)));
typedef float f32x2 __attribute__((ext_vector_type(2)));
typedef unsigned u32x4 __attribute__((ext_vector_type(4)));
typedef unsigned u32x2 __attribute__((ext_vector_type(2)));

constexpr int NB = 16, SEQ = 2048, NMETA = 16, TT = SEQ + NMETA, DM = 1024, DFF = 4096, NL = 4;
constexpr int MR = NB * SEQ;
constexpr int MT = MR + NMETA;
constexpr int INC = 3328;
constexpr int C_R = 0, C_K = 512, C_V = 1024, C_DW = 1536, C_DA = 1600, C_DG = 1664, C_Q = 1792, C_SK = 2304, C_SV = 2816;
constexpr int NWAVES = 8, NTHR = 512;
constexpr int LDS_BYTES = 147456;

constexpr size_t WS_CTL = 0;
constexpr size_t WS_BAR = 4096;
constexpr size_t WS_HM = 20480;
constexpr size_t WS_WIN = WS_HM + (size_t)NMETA * DM * 4;
constexpr size_t SZ_WIN = (size_t)INC * DM * 2;
constexpr size_t WS_WOUT = WS_WIN + NL * SZ_WIN;
constexpr size_t SZ_WOUT = (size_t)DM * DM * 2;
constexpr size_t WS_WUP = WS_WOUT + NL * SZ_WOUT;
constexpr size_t SZ_WUP = (size_t)DFF * DM * 2;
constexpr size_t WS_WDN = WS_WUP + NL * SZ_WUP;
constexpr size_t SZ_WDN = SZ_WUP;
constexpr size_t WS_WD = WS_WDN + NL * SZ_WDN;
constexpr size_t SZ_WD = (size_t)512 * 64 * 2;
constexpr size_t WS_WA = WS_WD + NL * SZ_WD;
constexpr size_t WS_WG = WS_WA + NL * SZ_WD;
constexpr size_t SZ_WG = (size_t)512 * 128 * 2;
constexpr size_t WS_RA = WS_WG + NL * SZ_WG;
constexpr size_t SZ_RA = (size_t)MT * DM * 2;
constexpr size_t WS_RB = WS_RA + SZ_RA;
constexpr size_t SZ_RB = (size_t)MT * DFF * 2;
constexpr size_t WS_T2HI = WS_RB + SZ_RB;
constexpr size_t WS_END = WS_T2HI + (size_t)MT * 512 * 4;

struct Params {
    const float* x; const float* meta; const float* g_pre_mix; const float* g_post_mix; const float* g_pre_ffn; const float* g_post_ffn;
    const float* w_in; const float* mu; const float* w_decay_up; const float* decay_bias; const float* w_a_up; const float* a_bias; const float* w_g_up;
    const float* k_k; const float* k_a; const float* r_k; const float* lnx_gain; const float* lnx_bias; const float* sb_gain;
    const float* w_out; const float* w_up; const float* w_dn;
    float* out; unsigned char* ws;
};

typedef const __attribute__((address_space(4))) Params* KParams;
__device__ __forceinline__ KParams kargs() { KParams k = (KParams)__builtin_amdgcn_kernarg_segment_ptr(); asm volatile("" : "+s"(k)); return k; }
__device__ __forceinline__ int ltid() { int t = threadIdx.x; asm volatile("" : "+v"(t)); return t; }
__device__ __forceinline__ unsigned f2bf(float f) { unsigned u = __builtin_bit_cast(unsigned, f); return (u + 0x7fffu + ((u >> 16) & 1u)) >> 16; }
__device__ __forceinline__ unsigned pk2(float lo, float hi) { unsigned r; asm volatile("v_cvt_pk_bf16_f32 %0, %1, %2" : "=v"(r) : "v"(lo), "v"(hi)); return r; }
__device__ __forceinline__ float bflo(unsigned u) { return __builtin_bit_cast(float, u << 16); }
__device__ __forceinline__ float bfhi(unsigned u) { return __builtin_bit_cast(float, u & 0xffff0000u); }
__device__ __forceinline__ int tokrow(int b, int t) { return t < NMETA ? MR + t : b * SEQ + (t - NMETA); }
__device__ __forceinline__ float wave_sum(float v) {
#pragma unroll
    for (int o = 1; o < 64; o <<= 1) v += __shfl_xor(v, o);
    return v;
}

template <int CTRL> __device__ __forceinline__ float dppf(float x) {
    return __builtin_bit_cast(float, __builtin_amdgcn_update_dpp(0, __builtin_bit_cast(int, x), CTRL, 0xF, 0xF, true));
}
__device__ __forceinline__ float sum8(float v) {
    v += dppf<0xB1>(v);
    v += dppf<0x4E>(v);
    v += dppf<0x141>(v);
    return v;
}
__device__ __forceinline__ float sum16(float v) {
    v += dppf<0xB1>(v);
    v += dppf<0x4E>(v);
    v += dppf<0x141>(v);
    v += dppf<0x140>(v);
    return v;
}
__device__ __forceinline__ float fast_exp(float x) { return __builtin_amdgcn_exp2f(x * 1.4426950408889634f); }
__device__ __forceinline__ float fast_log(float x) { return __builtin_amdgcn_logf(x) * 0.6931471805599453f; }
__device__ __forceinline__ float softplusf(float z) { return fmaxf(z, 0.f) + fast_log(1.f + fast_exp(-fabsf(z))); }
__device__ __forceinline__ float sigmoidf_(float z) { return __builtin_amdgcn_rcpf(1.f + fast_exp(-z)); }

template <class T> __device__ __forceinline__ T ldnt(const void* p) { return __builtin_nontemporal_load((const T*)p); }

struct EpiOut {
    static constexpr bool PERM = true, AFTER_DRAIN = false;
    bf16* O; int ldc; int act;
    __device__ __forceinline__ void operator()(const f32x4 (&acc)[2][2][4][2], const pg8::Unit& u, int wr, int wc, int fr, int fq) const {
        const int row0 = u.pm * 256 + wr * 64 + fr, col0 = u.pn * 256 + wc * 32 + 8 * fq;
#pragma unroll
        for (int ai = 0; ai < 2; ++ai)
#pragma unroll
            for (int m = 0; m < 4; ++m) { bf16* rowp = O + (size_t)(row0 + ai * 128 + m * 16) * ldc + col0;
#pragma unroll
                for (int bj = 0; bj < 2; ++bj) { f32x4 v0 = acc[ai][bj][m][0], v1 = acc[ai][bj][m][1];
                    if (act) {
#pragma unroll
                        for (int e = 0; e < 4; ++e) { float a = fmaxf(v0[e], 0.f), b = fmaxf(v1[e], 0.f); v0[e] = a * a; v1[e] = b * b; } }
                    u32x4 w; w.x = pk2(v0[0], v0[1]); w.y = pk2(v0[2], v0[3]); w.z = pk2(v1[0], v1[1]); w.w = pk2(v1[2], v1[3]);
                    *(u32x4*)(rowp + bj * 128) = w; } }
    }
};

struct EpiF32Split {
    static constexpr bool PERM = true, AFTER_DRAIN = false;
    float* lo; float* hi;
    __device__ __forceinline__ void operator()(const f32x4 (&acc)[2][2][4][2], const pg8::Unit& u, int wr, int wc, int fr, int fq) const {
        const int row0 = u.pm * 256 + wr * 64 + fr, col0 = (u.pn & 1) * 256 + wc * 32 + 8 * fq;
        float* base = (u.pn < 2) ? lo : hi;
#pragma unroll
        for (int ai = 0; ai < 2; ++ai)
#pragma unroll
            for (int m = 0; m < 4; ++m) { float* rowp = base + (size_t)(row0 + ai * 128 + m * 16) * 512 + col0;
#pragma unroll
                for (int bj = 0; bj < 2; ++bj) { *(f32x4*)(rowp + bj * 128) = acc[ai][bj][m][0]; *(f32x4*)(rowp + bj * 128 + 4) = acc[ai][bj][m][1]; } }
    }
};

__device__ __forceinline__ void meta_gemm(const bf16* A, const bf16* Bt, int N, int K, bf16* O, int act, LAS unsigned char* lds, int tid, float* flo = nullptr, float* fhi = nullptr) {
    const int lane = tid & 63, wave = tid >> 6, i = lane & 15, g = lane >> 4, kper = K / NWAVES;
    LAS f32x4* red = (LAS f32x4*)lds;
    for (int task = (int)gridDim.x - 1 - (int)blockIdx.x; task < N / 16; task += (int)gridDim.x) {
        const int n0 = task * 16;
        const bf16* ap = Bt + (size_t)(n0 + i) * K + wave * kper + 8 * g;
        const bf16* bp = A + (size_t)(MR + i) * K + wave * kper + 8 * g;
        f32x4 acc = {0.f, 0.f, 0.f, 0.f};
#pragma unroll 4
        for (int k0 = 0; k0 < kper; k0 += 32) {
            bf16x8 a = *(const bf16x8*)(ap + k0), b = *(const bf16x8*)(bp + k0);
            acc = __builtin_amdgcn_mfma_f32_16x16x32_bf16(a, b, acc, 0, 0, 0);
        }
        __syncthreads();
        red[wave * 64 + lane] = acc;
        __syncthreads();
        if (wave == 0) {
            f32x4 sum = red[lane];
#pragma unroll
            for (int w = 1; w < NWAVES; ++w) sum = sum + red[w * 64 + lane];
            if (act) {
#pragma unroll
                for (int e = 0; e < 4; ++e) { float a = fmaxf(sum[e], 0.f); sum[e] = a * a; } }
            if (flo) { float* base = (n0 < 512) ? flo : fhi; *(f32x4*)(base + (size_t)(MR + i) * 512 + (n0 & 511) + 4 * g) = sum; }
            else { u32x2 w; w.x = pk2(sum[0], sum[1]); w.y = pk2(sum[2], sum[3]); *(u32x2*)(O + (size_t)(MR + i) * N + n0 + 4 * g) = w; }
        }
    }
}

__device__ __forceinline__ void transpose_item(const float* W, int K, int N, bf16* WT, LAS float* scr, int item, int lane) {
    const int nblk = N / 32, kb = item / nblk, nb = item % nblk, k0 = 64 * kb, n0 = 32 * nb;
#pragma unroll 8
    for (int i = 0; i < 32; ++i) { const int kk = 2 * i + (lane >> 5); scr[kk * 33 + (lane & 31)] = W[(size_t)(k0 + kk) * N + n0 + (lane & 31)]; }
    asm volatile("s_waitcnt lgkmcnt(0)" ::: "memory");
    const int c = lane & 7;
#pragma unroll
    for (int j = 0; j < 4; ++j) { const int n = (lane >> 3) + 8 * j; const LAS float* s = scr + (8 * c) * 33 + n;
        u32x4 o; o.x = pk2(s[0 * 33], s[1 * 33]); o.y = pk2(s[2 * 33], s[3 * 33]); o.z = pk2(s[4 * 33], s[5 * 33]); o.w = pk2(s[6 * 33], s[7 * 33]);
        *(u32x4*)(WT + (size_t)(n0 + n) * K + k0 + 8 * c) = o; }
    asm volatile("s_waitcnt lgkmcnt(0)" ::: "memory");
}
__device__ __forceinline__ void conv_phase(const Params& p, LAS unsigned char* lds, int it_lo_layers, int it_hi_layers, int wg, int nwg, int mode = 0) {
    const int t_ = ltid(), lane = t_ & 63, wave = t_ >> 6, gw = wg * NWAVES + wave, ngw = nwg * NWAVES;
    LAS float* scr = (LAS float*)(lds + wave * 16384);
    constexpr int I_IN = 16 * 104, I_OUT = 16 * 32, I_UP = 16 * 128, I_DN = 64 * 32, I_D = 16, I_A = 16, I_G = 32;
    constexpr int PER = I_IN + I_OUT + I_UP + I_DN + I_D + I_A + I_G;
    for (int it = it_lo_layers * PER + gw; it < it_hi_layers * PER; it += ngw) {
        const int l = it / PER; int r = it % PER;
        { const bool early = (r < I_IN) || (r >= I_IN + I_OUT + I_UP + I_DN); if ((mode == 1 && !early) || (mode == 2 && early)) continue; }
        if (r < I_IN) { transpose_item(p.w_in + (size_t)l * DM * INC, DM, INC, (bf16*)(p.ws + WS_WIN + l * SZ_WIN), scr, r, lane); continue; } r -= I_IN;
        if (r < I_OUT) { transpose_item(p.w_out + (size_t)l * DM * DM, DM, DM, (bf16*)(p.ws + WS_WOUT + l * SZ_WOUT), scr, r, lane); continue; } r -= I_OUT;
        if (r < I_UP) { transpose_item(p.w_up + (size_t)l * DM * DFF, DM, DFF, (bf16*)(p.ws + WS_WUP + l * SZ_WUP), scr, r, lane); continue; } r -= I_UP;
        if (r < I_DN) { transpose_item(p.w_dn + (size_t)l * DFF * DM, DFF, DM, (bf16*)(p.ws + WS_WDN + l * SZ_WDN), scr, r, lane); continue; } r -= I_DN;
        if (r < I_D) { transpose_item(p.w_decay_up + (size_t)l * 64 * 512, 64, 512, (bf16*)(p.ws + WS_WD + l * SZ_WD), scr, r, lane); continue; } r -= I_D;
        if (r < I_A) { transpose_item(p.w_a_up + (size_t)l * 64 * 512, 64, 512, (bf16*)(p.ws + WS_WA + l * SZ_WD), scr, r, lane); continue; } r -= I_A;
        transpose_item(p.w_g_up + (size_t)l * 128 * 512, 128, 512, (bf16*)(p.ws + WS_WG + l * SZ_WG), scr, r, lane);
    }
}

__device__ __forceinline__ void norm_phase(const float* T, const float* Thi, const float* g1, const float* hin_real, const float* hin_meta, float* hout_real, float* hout_meta,
                                           const float* g2, bf16* xn) {
    const int t_ = ltid(), lane = t_ & 63, gw = blockIdx.x * NWAVES + (t_ >> 6), ngw = gridDim.x * NWAVES;
    for (int m = gw; m < MT; m += ngw) {
        const float* hi = m < MR ? hin_real + (size_t)m * DM : hin_meta + (size_t)(m - MR) * DM;
        float* ho = m < MR ? hout_real + (size_t)m * DM : hout_meta + (size_t)(m - MR) * DM;
        f32x4 h[4];
#pragma unroll
        for (int j = 0; j < 4; ++j) h[j] = *((const f32x4*)hi + lane + 64 * j);
        if (T) {
            f32x4 t[4]; float ss = 0.f;
#pragma unroll
            for (int j = 0; j < 4; ++j) { t[j] = *((const f32x4*)((j < 2 ? T : Thi) + (size_t)m * 512) + lane + 64 * (j & 1));
                ss += (t[j].x * t[j].x + t[j].y * t[j].y) + (t[j].z * t[j].z + t[j].w * t[j].w); }
            const float r1 = 1.f / sqrtf(wave_sum(ss) * (1.f / DM) + 1e-6f);
#pragma unroll
            for (int j = 0; j < 4; ++j) { f32x4 gg = *((const f32x4*)g1 + lane + 64 * j); h[j] = h[j] + t[j] * r1 * gg; *((f32x4*)ho + lane + 64 * j) = h[j]; }
        }
        if (g2) {
            float ss = 0.f;
#pragma unroll
            for (int j = 0; j < 4; ++j) ss += (h[j].x * h[j].x + h[j].y * h[j].y) + (h[j].z * h[j].z + h[j].w * h[j].w);
            const float r2 = 1.f / sqrtf(wave_sum(ss) * (1.f / DM) + 1e-6f);
            u32x2* o = (u32x2*)(xn + (size_t)m * DM) + lane;
#pragma unroll
            for (int j = 0; j < 4; ++j) { f32x4 gg = *((const f32x4*)g2 + lane + 64 * j); f32x4 v = h[j] * r2 * gg;
                u32x2 w; w.x = pk2(v.x, v.y); w.y = pk2(v.z, v.w); o[64 * j] = w; }
        }
    }
}

constexpr int RW_CH = 32;
constexpr int RW_R = 0, RW_W = 8192, RW_K = 16384, RW_V = 24576, RW_KKN = 32768, RW_B = 40960, RW_Y = 49152, RW_G = 57344;
constexpr int RW_TD = 65536, RW_DA = 70144, RW_SG = 74752, RW_BON = 83456;

__device__ __forceinline__ void rwkv_chain(const Params& p, int l, int b, int h, LAS unsigned char* lds, int tid) {
    const int wave = tid >> 6, lane = tid & 63;
    const bf16* P = (const bf16*)(p.ws + WS_RB);
    bf16* Yo = (bf16*)(p.ws + WS_RA);
    LAS float* R = (LAS float*)(lds + RW_R); LAS float* W = (LAS float*)(lds + RW_W); LAS float* Kx = (LAS float*)(lds + RW_K); LAS float* V = (LAS float*)(lds + RW_V);
    LAS float* KKN = (LAS float*)(lds + RW_KKN); LAS float* BV = (LAS float*)(lds + RW_B); LAS float* Y = (LAS float*)(lds + RW_Y); LAS float* G = (LAS float*)(lds + RW_G);
    LAS bf16* TD = (LAS bf16*)(lds + RW_TD); LAS bf16* DA = (LAS bf16*)(lds + RW_DA); LAS bf16* SG = (LAS bf16*)(lds + RW_SG); LAS float* BON = (LAS float*)(lds + RW_BON);
    const float* mu = p.mu + (size_t)l * 1792;
    const int mt = wave & 1, nt = wave >> 1, fi = lane & 15, fg = lane >> 4;
    bf16x8 wdF[2], waF[2], wgF[4];
    {
        const bf16* wd = (const bf16*)(p.ws + WS_WD + l * SZ_WD) + (size_t)(h * 64 + nt * 16 + fi) * 64 + 8 * fg;
        const bf16* wa = (const bf16*)(p.ws + WS_WA + l * SZ_WD) + (size_t)(h * 64 + nt * 16 + fi) * 64 + 8 * fg;
        const bf16* wg = (const bf16*)(p.ws + WS_WG + l * SZ_WG) + (size_t)(h * 64 + nt * 16 + fi) * 128 + 8 * fg;
        wdF[0] = *(const bf16x8*)wd; wdF[1] = *(const bf16x8*)(wd + 32);
        waF[0] = *(const bf16x8*)wa; waF[1] = *(const bf16x8*)(wa + 32);
#pragma unroll
        for (int k = 0; k < 4; ++k) wgF[k] = *(const bf16x8*)(wg + 32 * k);
    }
    const int cB = h * 64 + nt * 16 + fi;
    const float dbias = p.decay_bias[l * 512 + cB], abias = p.a_bias[l * 512 + cB];
    const int tokC = tid >> 4, ch4 = (tid & 15) * 4, cC = h * 64 + ch4;
    const f32x4 kkv = *(const f32x4*)(p.k_k + l * 512 + cC), kav = *(const f32x4*)(p.k_a + l * 512 + cC), rkv = *(const f32x4*)(p.r_k + l * 512 + cC);
    const f32x4 lgv = *(const f32x4*)(p.lnx_gain + l * 512 + cC), lbv = *(const f32x4*)(p.lnx_bias + l * 512 + cC);
    const int vrow = (tid >> 3) & 31, kq = tid & 7;
    f32x2 S[2][4];
#pragma unroll
    for (int q = 0; q < 2; ++q)
#pragma unroll
        for (int j = 0; j < 4; ++j) S[q][j] = (f32x2){0.f, 0.f};

    u32x4 pc[4], pp[4];
    LAS float* MU = (LAS float*)(lds + 83968);
    if (tid < 448) { const int gi = tid >> 3; const int col = gi < 24 ? (gi >> 3) * 512 + h * 64 + (gi & 7) * 8 : C_DW + (gi - 24) * 8; MU[tid] = mu[col + (tid & 7)]; }
#pragma unroll
    for (int k = 0; k < 4; ++k) { pc[k] = (u32x4){0u, 0u, 0u, 0u}; pp[k] = pc[k]; }
#define RW_IK(k) (((tid + NTHR * (k)) * 4682) >> 18)
#define RW_GIK(k) ((tid + NTHR * (k)) - 56 * RW_IK(k))
#define RW_COL(gi) ((gi) < 24 ? ((gi) >> 3) * 512 + h * 64 + ((gi) & 7) * 8 : C_DW + ((gi) - 24) * 8)
#define RW_ISSUE(T0, NT) do { _Pragma("unroll") for (int k = 0; k < 4; ++k) { if (tid + NTHR * k < (NT) * 56) { const int t_ = (T0) + RW_IK(k); const int c_ = RW_COL(RW_GIK(k)); \
        pc[k] = ldnt<u32x4>(P + (size_t)tokrow(b, t_) * INC + c_); pp[k] = (u32x4){0u, 0u, 0u, 0u}; \
        if (t_ > 0) pp[k] = ldnt<u32x4>(P + (size_t)tokrow(b, t_ - 1) * INC + c_); } } } while (0)
    RW_ISSUE(0, NMETA);
    __syncthreads();
    for (int t0 = 0; t0 < TT; ) {
        const int ntok = (t0 == 0) ? NMETA : RW_CH;
#pragma unroll
        for (int k = 0; k < 4; ++k) {
            if (tid + NTHR * k < ntok * 56) {
                const int i = RW_IK(k), gi = RW_GIK(k);
                float xv[8];
                {
                    const unsigned cu[4] = {pc[k].x, pc[k].y, pc[k].z, pc[k].w}, pu[4] = {pp[k].x, pp[k].y, pp[k].z, pp[k].w};
                    const f32x4 ma = *(const LAS f32x4*)(MU + gi * 8), mb = *(const LAS f32x4*)(MU + gi * 8 + 4);
                    const float mm[8] = {ma.x, ma.y, ma.z, ma.w, mb.x, mb.y, mb.z, mb.w};
#pragma unroll
                    for (int e = 0; e < 4; ++e) { float c0 = bflo(cu[e]), c1 = bfhi(cu[e]), q0 = bflo(pu[e]), q1 = bfhi(pu[e]);
                        xv[2 * e] = c0 + (q0 - c0) * mm[2 * e]; xv[2 * e + 1] = c1 + (q1 - c1) * mm[2 * e + 1]; }
                }
                if (gi < 24) {
                    LAS float* dst = (gi < 8 ? R : (gi < 16 ? Kx : V)) + i * 64 + (gi & 7) * 8;
                    *(LAS f32x4*)dst = (f32x4){xv[0], xv[1], xv[2], xv[3]}; *(LAS f32x4*)(dst + 4) = (f32x4){xv[4], xv[5], xv[6], xv[7]};
                } else if (gi >= 32 && gi < 40) {
                    u32x4 w; w.x = pk2(xv[0], xv[1]); w.y = pk2(xv[2], xv[3]); w.z = pk2(xv[4], xv[5]); w.w = pk2(xv[6], xv[7]);
                    *(LAS u32x4*)(DA + i * 72 + (gi - 32) * 8) = w;
                } else {
                    const bool th = gi < 32; const float sc = th ? 2.f : 1.f, ka = th ? 2.f : 1.f, kb = th ? -1.f : 0.f;
                    float tv[8];
#pragma unroll
                    for (int e = 0; e < 8; ++e) tv[e] = ka * sigmoidf_(sc * xv[e]) + kb;
                    u32x4 w; w.x = pk2(tv[0], tv[1]); w.y = pk2(tv[2], tv[3]); w.z = pk2(tv[4], tv[5]); w.w = pk2(tv[6], tv[7]);
                    LAS bf16* dstb = th ? TD + i * 72 + (gi - 24) * 8 : SG + i * 136 + (gi - 40) * 8;
                    *(LAS u32x4*)dstb = w;
                }
            }
        }
        __syncthreads();
#ifndef ISSUE_LATE
        if (t0 + ntok < TT) RW_ISSUE(t0 + ntok, RW_CH);
#endif
        {
            f32x4 ad = {0.f, 0.f, 0.f, 0.f}, aa = ad, ag = ad;
#pragma unroll
            for (int ks = 0; ks < 2; ++ks) {
                bf16x8 fa = *(const LAS bf16x8*)(TD + (16 * mt + fi) * 72 + 32 * ks + 8 * fg);
                ad = __builtin_amdgcn_mfma_f32_16x16x32_bf16(fa, wdF[ks], ad, 0, 0, 0);
                bf16x8 fb = *(const LAS bf16x8*)(DA + (16 * mt + fi) * 72 + 32 * ks + 8 * fg);
                aa = __builtin_amdgcn_mfma_f32_16x16x32_bf16(fb, waF[ks], aa, 0, 0, 0);
            }
#pragma unroll
            for (int ks = 0; ks < 4; ++ks) {
                bf16x8 fc = *(const LAS bf16x8*)(SG + (16 * mt + fi) * 136 + 32 * ks + 8 * fg);
                ag = __builtin_amdgcn_mfma_f32_16x16x32_bf16(fc, wgF[ks], ag, 0, 0, 0);
            }
#pragma unroll
            for (int r = 0; r < 4; ++r) {
                const int tok = 16 * mt + 4 * fg + r, o = tok * 64 + nt * 16 + fi;
                const float xd = dbias + ad[r];
                const float wlog = -softplusf(-xd) - 0.5f;
                W[o] = fast_exp(-fast_exp(wlog));
                BV[o] = sigmoidf_(abias + aa[r]);
                G[o] = ag[r];
            }
        }
        __syncthreads();
        {
            const int o = tokC * 64 + ch4;
            const f32x4 k = *(const LAS f32x4*)(Kx + o), a = *(const LAS f32x4*)(BV + o), r = *(const LAS f32x4*)(R + o);
            f32x4 kk = k * kkv;
            const float ss = sum16((kk.x * kk.x + kk.y * kk.y) + (kk.z * kk.z + kk.w * kk.w));
            const float inv = 1.f / sqrtf(ss + 1e-12f);
            kk = kk * inv;
            const f32x4 km = k * (1.f + (a - 1.f) * kav);
            const f32x4 bb = r * km * rkv;
            const float bon = sum16((bb.x + bb.y) + (bb.z + bb.w));
            *(LAS f32x4*)(KKN + o) = -kk; *(LAS f32x4*)(BV + o) = kk * a; *(LAS f32x4*)(Kx + o) = km;
            if ((tid & 15) == 0) BON[tokC] = bon;
        }
        __syncthreads();
#ifdef ISSUE_LATE
        if (t0 + ntok < TT) RW_ISSUE(t0 + ntok, RW_CH);
#endif
        if (tid < 256) {
#ifndef SCAN_UNROLL
#define SCAN_UNROLL 2
#endif
#pragma unroll SCAN_UNROLL
            for (int i = 0; i < ntok; ++i) {
                const int o = i * 64 + kq * 8;
                const f32x4 n0 = *(const LAS f32x4*)(KKN + o), n1 = *(const LAS f32x4*)(KKN + o + 4);
                const f32x4 w0 = *(const LAS f32x4*)(W + o), w1 = *(const LAS f32x4*)(W + o + 4);
                const f32x4 b0 = *(const LAS f32x4*)(BV + o), b1 = *(const LAS f32x4*)(BV + o + 4);
                const f32x4 k0 = *(const LAS f32x4*)(Kx + o), k1 = *(const LAS f32x4*)(Kx + o + 4);
                const f32x4 r0 = *(const LAS f32x4*)(R + o), r1 = *(const LAS f32x4*)(R + o + 4);
                const f32x2 vpair = *(const LAS f32x2*)(V + i * 64 + 2 * vrow);
                const f32x2 nn[4] = {{n0.x, n0.y}, {n0.z, n0.w}, {n1.x, n1.y}, {n1.z, n1.w}};
                const f32x2 ww[4] = {{w0.x, w0.y}, {w0.z, w0.w}, {w1.x, w1.y}, {w1.z, w1.w}};
                const f32x2 bb[4] = {{b0.x, b0.y}, {b0.z, b0.w}, {b1.x, b1.y}, {b1.z, b1.w}};
                const f32x2 kk2[4] = {{k0.x, k0.y}, {k0.z, k0.w}, {k1.x, k1.y}, {k1.z, k1.w}};
                const f32x2 rr2[4] = {{r0.x, r0.y}, {r0.z, r0.w}, {r1.x, r1.y}, {r1.z, r1.w}};
                float sa[2], yy[2];
#pragma unroll
                for (int q = 0; q < 2; ++q) {
                    f32x2 s2 = S[q][0] * nn[0];
                    s2 = __builtin_elementwise_fma(S[q][1], nn[1], s2);
                    f32x2 s3 = S[q][2] * nn[2];
                    s3 = __builtin_elementwise_fma(S[q][3], nn[3], s3);
                    s2 = s2 + s3;
                    sa[q] = s2.x + s2.y;
                }
                sa[0] += dppf<0xB1>(sa[0]); sa[1] += dppf<0xB1>(sa[1]);
                sa[0] += dppf<0x4E>(sa[0]); sa[1] += dppf<0x4E>(sa[1]);
                sa[0] += dppf<0x141>(sa[0]); sa[1] += dppf<0x141>(sa[1]);
#pragma unroll
                for (int q = 0; q < 2; ++q) {
                    const f32x2 sa2 = {sa[q], sa[q]}, vv2 = {vpair[q], vpair[q]};
#pragma unroll
                    for (int j = 0; j < 4; ++j) S[q][j] = __builtin_elementwise_fma(S[q][j], ww[j], __builtin_elementwise_fma(sa2, bb[j], vv2 * kk2[j]));
                    f32x2 y2 = S[q][0] * rr2[0];
                    y2 = __builtin_elementwise_fma(S[q][1], rr2[1], y2);
                    f32x2 y3 = S[q][2] * rr2[2];
                    y3 = __builtin_elementwise_fma(S[q][3], rr2[3], y3);
                    y2 = y2 + y3;
                    yy[q] = y2.x + y2.y;
                }
                yy[0] += dppf<0xB1>(yy[0]); yy[1] += dppf<0xB1>(yy[1]);
                yy[0] += dppf<0x4E>(yy[0]); yy[1] += dppf<0x4E>(yy[1]);
                yy[0] += dppf<0x141>(yy[0]); yy[1] += dppf<0x141>(yy[1]);
                if (kq == 0) *(LAS f32x2*)(Y + i * 64 + 2 * vrow) = (f32x2){yy[0], yy[1]};
            }
        }
        __syncthreads();
        if (tokC < ntok && (t0 > 0 || b == 0)) {
            const int o = tokC * 64 + ch4;
            const f32x4 y = *(const LAS f32x4*)(Y + o);
            const float mean = sum16((y.x + y.y) + (y.z + y.w)) * (1.f / 64.f);
            const f32x4 d = y - mean;
            const float var = sum16((d.x * d.x + d.y * d.y) + (d.z * d.z + d.w * d.w)) * (1.f / 64.f);
            const float rs = 1.f / sqrtf(var + 6.4e-4f);
            f32x4 yn = d * rs * lgv + lbv;
            const f32x4 vv = *(const LAS f32x4*)(V + o), gg = *(const LAS f32x4*)(G + o);
            yn = (yn + BON[tokC] * vv) * gg;
            u32x2 w; w.x = pk2(yn.x, yn.y); w.y = pk2(yn.z, yn.w);
            *(u32x2*)(Yo + (size_t)tokrow(b, t0 + tokC) * DM + cC) = w;
        } else if (tokC < ntok) {
        }
        __syncthreads();
        t0 += ntok;
    }
}

constexpr int SB_KS = 0, SB_VT = 9216, SB_Q = 18432;
#ifndef SB_THR_VAL
#define SB_THR_VAL 90.f
#endif
constexpr float SB_THR = SB_THR_VAL;

__device__ __forceinline__ void sb_unit(const Params& p, int l, int b, int h, int qb, LAS unsigned char* lds, int tid) {
    const int wave = tid >> 6, lane = tid & 63, ql = lane & 15, g = lane >> 4;
    const bf16* P = (const bf16*)(p.ws + WS_RB);
    bf16* Yo = (bf16*)(p.ws + WS_RA);
    LAS bf16* Ks = (LAS bf16*)(lds + SB_KS); LAS bf16* Vt = (LAS bf16*)(lds + SB_VT);
    const int tq = (qb < 0 ? 0 : NMETA + 128 * qb) + 16 * wave + ql;
    const bool wave_valid = (qb >= 0) || (wave == 0);
    const int tqc = wave_valid ? tq : 0;
    bf16x8 qF[2];
    {
        const bf16* qp = P + (size_t)tokrow(b, tqc) * INC + C_Q + h * 64 + 8 * g;
        qF[0] = ldnt<bf16x8>(qp); qF[1] = ldnt<bf16x8>(qp + 32);
    }
    unsigned P01, P23; const unsigned ONES = 0x3F803F80u;
    { const unsigned p0 = (4 * g + 0 > ql) ? 0x3F80u : 0u, p1 = (4 * g + 1 > ql) ? 0x3F80u : 0u, p2 = (4 * g + 2 > ql) ? 0x3F80u : 0u, p3 = (4 * g + 3 > ql) ? 0x3F80u : 0u;
      P01 = p0 | (p1 << 16); P23 = p2 | (p3 << 16); }
    const bf16x8 FA = __builtin_bit_cast(bf16x8, (u32x4){P01, P23, ONES, ONES});
    const bf16x8 FB = __builtin_bit_cast(bf16x8, (u32x4){0u, 0u, P01, P23});
    const bf16x8 F1 = __builtin_bit_cast(bf16x8, (u32x4){ONES, ONES, ONES, ONES});
    f32x4 O[4];
#pragma unroll
    for (int d = 0; d < 4; ++d) O[d] = (f32x4){0.f, 0.f, 0.f, 0.f};
    float carry = 0.f;
    const int wave_tq_max = (qb < 0 ? 0 : NMETA + 128 * qb) + 16 * wave + 15;
    const int i_hi = qb < 0 ? 0 : 2 * qb + 2;
    const int kap = tid >> 3, piece = tid & 7;
    const int slot = (kap >> 5) * 32 + ((kap >> 2) & 3) * 8 + ((kap >> 4) & 1) * 4 + (kap & 3);
    bool wave_done = !wave_valid;
    volatile LAS unsigned* orw = (volatile LAS unsigned*)(lds + SB_Q + 16);
    if (tid < 2) orw[tid] = 0u;
    int nit = 0;
    for (int it = i_hi; it >= 0; --it, ++nit) {
        const int tk0 = NMETA + 64 * (it - 1);
        {
            const int tk = tk0 + kap;
            u32x4 kv = {0u, 0u, 0u, 0u}, vv = kv;
            if (tk >= 0) { const bf16* rp = P + (size_t)tokrow(b, tk) * INC + h * 64 + piece * 8; kv = ldnt<u32x4>(rp + C_SK); vv = ldnt<u32x4>(rp + C_SV); }
            *(LAS u32x4*)(Ks + kap * 72 + piece * 8) = kv;
            const unsigned vu[4] = {vv.x, vv.y, vv.z, vv.w};
#pragma unroll
            for (int e = 0; e < 4; ++e) { Vt[(piece * 8 + 2 * e) * 72 + slot] = (bf16)(vu[e] & 0xffffu); Vt[(piece * 8 + 2 * e + 1) * 72 + slot] = (bf16)(vu[e] >> 16); }
        }
        __syncthreads();
        if (!wave_done && tk0 < wave_tq_max) {
            f32x4 s[4];
#pragma unroll
            for (int m = 0; m < 4; ++m) {
                s[m] = (f32x4){0.f, 0.f, 0.f, 0.f};
#pragma unroll
                for (int ks = 0; ks < 2; ++ks) {
                    bf16x8 a = *(const LAS bf16x8*)(Ks + (16 * m + ql) * 72 + 32 * ks + 8 * g);
                    s[m] = __builtin_amdgcn_mfma_f32_16x16x32_bf16(a, qF[ks], s[m], 0, 0, 0);
                }
            }
            float z[4][4], sp[4][4]; bool val[4][4];
            unsigned hi[4][2], lo[4][2];
#pragma unroll
            for (int m = 0; m < 4; ++m) {
#pragma unroll
                for (int r = 0; r < 4; ++r) {
                    const int tk = tk0 + 16 * m + 4 * g + r;
                    val[m][r] = (tk >= 0) && (tk < tq);
                    z[m][r] = s[m][r] * 0.125f;
                    sp[m][r] = val[m][r] ? softplusf(z[m][r]) : 0.f;
                }
#pragma unroll
                for (int r2 = 0; r2 < 2; ++r2) {
                    const unsigned hh = pk2(sp[m][2 * r2], sp[m][2 * r2 + 1]);
                    hi[m][r2] = hh;
                    lo[m][r2] = pk2(sp[m][2 * r2] - bflo(hh), sp[m][2 * r2 + 1] - bfhi(hh));
                }
            }
            const bf16x8 hF0 = __builtin_bit_cast(bf16x8, (u32x4){hi[0][0], hi[0][1], hi[1][0], hi[1][1]});
            const bf16x8 hF1 = __builtin_bit_cast(bf16x8, (u32x4){hi[2][0], hi[2][1], hi[3][0], hi[3][1]});
            const bf16x8 lF0 = __builtin_bit_cast(bf16x8, (u32x4){lo[0][0], lo[0][1], lo[1][0], lo[1][1]});
            const bf16x8 lF1 = __builtin_bit_cast(bf16x8, (u32x4){lo[2][0], lo[2][1], lo[3][0], lo[3][1]});
            f32x4 cum[4];
            const f32x4 zero4 = {0.f, 0.f, 0.f, 0.f};
            cum[0] = __builtin_amdgcn_mfma_f32_16x16x32_bf16(FA, hF0, zero4, 0, 0, 0);
            cum[0] = __builtin_amdgcn_mfma_f32_16x16x32_bf16(FA, lF0, cum[0], 0, 0, 0);
            cum[0] = __builtin_amdgcn_mfma_f32_16x16x32_bf16(F1, hF1, cum[0], 0, 0, 0);
            cum[0] = __builtin_amdgcn_mfma_f32_16x16x32_bf16(F1, lF1, cum[0], 0, 0, 0);
            cum[1] = __builtin_amdgcn_mfma_f32_16x16x32_bf16(FB, hF0, zero4, 0, 0, 0);
            cum[1] = __builtin_amdgcn_mfma_f32_16x16x32_bf16(FB, lF0, cum[1], 0, 0, 0);
            cum[1] = __builtin_amdgcn_mfma_f32_16x16x32_bf16(F1, hF1, cum[1], 0, 0, 0);
            cum[1] = __builtin_amdgcn_mfma_f32_16x16x32_bf16(F1, lF1, cum[1], 0, 0, 0);
            cum[2] = __builtin_amdgcn_mfma_f32_16x16x32_bf16(FA, hF1, zero4, 0, 0, 0);
            cum[2] = __builtin_amdgcn_mfma_f32_16x16x32_bf16(FA, lF1, cum[2], 0, 0, 0);
            cum[3] = __builtin_amdgcn_mfma_f32_16x16x32_bf16(FB, hF1, zero4, 0, 0, 0);
            cum[3] = __builtin_amdgcn_mfma_f32_16x16x32_bf16(FB, lF1, cum[3], 0, 0, 0);
            unsigned af[4][2];
#pragma unroll
            for (int m = 0; m < 4; ++m) {
                float av[4];
#pragma unroll
                for (int r = 0; r < 4; ++r) { const float la = (z[m][r] - sp[m][r]) - cum[m][r] - carry; av[r] = val[m][r] ? fast_exp(la) : 0.f; }
                af[m][0] = pk2(av[0], av[1]); af[m][1] = pk2(av[2], av[3]);
            }
            const bf16x8 aF0 = __builtin_bit_cast(bf16x8, (u32x4){af[0][0], af[0][1], af[1][0], af[1][1]});
            const bf16x8 aF1 = __builtin_bit_cast(bf16x8, (u32x4){af[2][0], af[2][1], af[3][0], af[3][1]});
            const float tot = __shfl(cum[0][0] + sp[0][0], ql);
            carry += tot;
#pragma unroll
            for (int d = 0; d < 4; ++d) {
                bf16x8 v0 = *(const LAS bf16x8*)(Vt + (16 * d + ql) * 72 + 8 * g);
                bf16x8 v1 = *(const LAS bf16x8*)(Vt + (16 * d + ql) * 72 + 32 + 8 * g);
                O[d] = __builtin_amdgcn_mfma_f32_16x16x32_bf16(v0, aF0, O[d], 0, 0, 0);
                O[d] = __builtin_amdgcn_mfma_f32_16x16x32_bf16(v1, aF1, O[d], 0, 0, 0);
            }
            if (__all(carry > SB_THR)) wave_done = true;
        }
        if (lane == 0 && !wave_done && it > 0) orw[nit & 1] = 1u;
        __syncthreads();
        const unsigned more = orw[nit & 1];
        if (tid == 0) orw[(nit + 1) & 1] = 0u;
        if (!more) break;
    }
    if (wave_valid && (qb >= 0 || b == 0)) {
        float ss = 0.f;
#pragma unroll
        for (int d = 0; d < 4; ++d) ss += (O[d].x * O[d].x + O[d].y * O[d].y) + (O[d].z * O[d].z + O[d].w * O[d].w);
        ss += __shfl_xor(ss, 16); ss += __shfl_xor(ss, 32);
        const float inv = 1.f / sqrtf(ss * (1.f / 64.f) + 1e-6f);
        bf16* yp = Yo + (size_t)tokrow(b, tq) * DM + 512 + h * 64;
        const float* gp = p.sb_gain + l * 512 + h * 64;
#pragma unroll
        for (int d = 0; d < 4; ++d) {
            const f32x4 gg = *(const f32x4*)(gp + 16 * d + 4 * g);
            const f32x4 v = O[d] * inv * gg;
            u32x2 w; w.x = pk2(v.x, v.y); w.y = pk2(v.z, v.w);
            *(u32x2*)(yp + 16 * d + 4 * g) = w;
        }
    }
}

__device__ __forceinline__ void mix_phase(const Params& p_in, int l, LAS unsigned char* lds, int cslot = -1) {
#if defined(__HIP_DEVICE_COMPILE__)
    const Params p = *kargs();
#else
    const Params& p = p_in;
#endif
    const int tid = ltid();
    const int G = gridDim.x;
#ifdef CHAINS_HIGH
    for (int c = (int)blockIdx.x - (G - NB * 8); c < NB * 8; c += G) if (c >= 0) rwkv_chain(
#else
    for (int c = blockIdx.x; c < NB * 8; c += G) rwkv_chain(
#endif
    p, l, c >> 3, c & 7, lds, tid);
    unsigned* ctr = (unsigned*)(p.ws + WS_CTL) + 64 * (cslot < 0 ? l + 1 : cslot);
    volatile LAS unsigned* qw = (volatile LAS unsigned*)(lds + SB_Q);
    for (;;) {
        __syncthreads();
        if (tid == 0) qw[0] = atomicAdd(ctr, 1u);
        __syncthreads();
        const unsigned u = qw[0];
        if (u >= 2048u + 8u) break;
        if (u < 2048u) { const int qb = 15 - (int)(u >> 7), bh = (int)(u & 127u); sb_unit(p, l, bh >> 3, bh & 7, qb, lds, tid); }
        else sb_unit(p, l, 0, (int)(u - 2048u), -1, lds, tid);
    }
    if (l == 0 && (int)blockIdx.x >= NB * 8) {
        __syncthreads();
        conv_phase(p, lds, 0, 1, (int)blockIdx.x - NB * 8, G - NB * 8, 2);
        conv_phase(p, lds, 1, NL, (int)blockIdx.x - NB * 8, G - NB * 8);
    }
}


#ifdef DIAG_W
__device__ __forceinline__ bool check_win(const Params& p) {
    const int t = ltid(), xl = blockIdx.x >> 3, nxl = gridDim.x >> 3;
    bool bad = false;
    for (int l = 0; l < NL; ++l) {
        const float* W = p.w_in + (size_t)l * DM * INC; const bf16* WT = (const bf16*)(p.ws + WS_WIN + l * SZ_WIN);
        for (int g = xl * NTHR + t; g < INC * (DM / 8); g += nxl * NTHR) {
            const int n = g / (DM / 8), k0 = (g % (DM / 8)) * 8;
            const u32x4 v = *(const u32x4*)(WT + (size_t)n * DM + k0);
            const unsigned vv[4] = {v.x, v.y, v.z, v.w};
#pragma unroll
            for (int j = 0; j < 4; ++j) { const unsigned e = pk2(W[(size_t)(k0 + 2 * j) * INC + n], W[(size_t)(k0 + 2 * j + 1) * INC + n]); bad |= (e != vv[j]); }
        }
    }
    return __any(bad);
}
#endif

#define XB_TMO      128
#define XB_XCNT(j)  (256  + 64 * (j))
#define XB_XSUB(j)  (1280 + 64 * (j))
#define XB_XGEN(j)  (2304 + 64 * (j))
#define XB_TOP      3328
#define XB_TOPGEN   3392
#define XCD_BAR_WORDS 3456
#define XB_SPIN_CAP (1u << 18)

__device__ __forceinline__ unsigned xb_ld(unsigned* p)              { return __hip_atomic_load(p, __ATOMIC_RELAXED, __HIP_MEMORY_SCOPE_AGENT); }
__device__ __forceinline__ unsigned xb_add(unsigned* p, unsigned v) { return __hip_atomic_fetch_add(p, v, __ATOMIC_RELAXED, __HIP_MEMORY_SCOPE_AGENT); }
__device__ __forceinline__ unsigned xb_xcc_id() { return (unsigned)__builtin_amdgcn_s_getreg((3 << 11) | 20) & 0xFu; }
#define XB_SPIN(cond, bar) do { unsigned _sp = 0; while (cond) { __builtin_amdgcn_s_sleep(1); \
    if ((++_sp & 255u) == 0u) { if (xb_ld(&(bar)[XB_TMO])) break; if (_sp > XB_SPIN_CAP) { atomicAdd(&(bar)[XB_TMO], 1u); break; } } } } while (0)

struct XcdBarrier {
    unsigned* bar; unsigned x;
    volatile LAS unsigned* st;
};

__device__ __forceinline__ XcdBarrier xcd_barrier_post(unsigned* bar, volatile LAS unsigned* st) {
    XcdBarrier b; b.bar = bar; b.x = xb_xcc_id(); b.st = st;
    if (threadIdx.x == 0) (void)xb_add(&bar[XB_XCNT(b.x)], 1u);
    return b;
}
__device__ __forceinline__ void xcd_barrier_complete(unsigned* bar, unsigned x, unsigned& nloc, unsigned& nx) {
    const unsigned G = gridDim.x * gridDim.y * gridDim.z;
    unsigned sum, cnt, mine, sp = 0u;
    for (;;) {
        sum = 0u; cnt = 0u; mine = 0u;
#pragma unroll
        for (unsigned j = 0; j < 16; ++j) { const unsigned c = xb_ld(&bar[XB_XCNT(j)]); sum += c; cnt += (c > 0u) ? 1u : 0u; mine = (j == x) ? c : mine; }
        if (sum == G) break;
        __builtin_amdgcn_s_sleep(1);
        if ((++sp & 255u) == 0u) { if (xb_ld(&bar[XB_TMO])) break; if (sp > XB_SPIN_CAP) { atomicAdd(&bar[XB_TMO], 1u); break; } }
    }
    nloc = mine > 0u ? mine : 1u; nx = cnt > 0u ? cnt : 1u;
}

__device__ __forceinline__ void xcd_barrier(const XcdBarrier& b) {
    asm volatile("s_waitcnt vmcnt(0)" ::: "memory");
    __syncthreads();
    if (threadIdx.x == 0) {
        unsigned* bar = b.bar;
        __builtin_amdgcn_s_waitcnt(0);
        unsigned nloc = b.st[0], nx = b.st[1];
        if (nloc == 0u) { xcd_barrier_complete(bar, b.x, nloc, nx); b.st[0] = nloc; b.st[1] = nx; }
        const unsigned old = xb_add(&bar[XB_XSUB(b.x)], 1u);
        const unsigned gen = old / nloc;
        if (old + 1u == (gen + 1u) * nloc) {
            __builtin_amdgcn_fence(__ATOMIC_RELEASE, "agent");
            asm volatile("s_waitcnt vmcnt(0)" ::: "memory");
            const unsigned og = xb_add(&bar[XB_TOP], 1u);
            const unsigned tg = og / nx;
            if (og + 1u == (tg + 1u) * nx) xb_add(&bar[XB_TOPGEN], 1u);
            else XB_SPIN(xb_ld(&bar[XB_TOPGEN]) == tg, bar);
            __builtin_amdgcn_fence(__ATOMIC_ACQUIRE, "agent");
            xb_add(&bar[XB_XGEN(b.x)], 1u);
            asm volatile("s_waitcnt vmcnt(0)" ::: "memory");
        } else {
            XB_SPIN(xb_ld(&bar[XB_XGEN(b.x)]) == gen, bar);
            __builtin_amdgcn_fence(__ATOMIC_ACQUIRE, "agent");
            asm volatile("s_waitcnt vmcnt(0)" ::: "memory");
        }
    }
    __syncthreads();
}

template <int N, int K, int ACT>
__device__ __forceinline__ void gemm_call(const bf16* A, const bf16* Bt, bf16* O, LAS unsigned char* lds) {
    pg8::Gemm gm{A, Bt, MR, N, K};
    pg8::StaticOrder S; S.init(MR, N, gridDim.x, blockIdx.x);
    EpiOut E{O, N, ACT};
    pg8::gemm_phase<EpiOut, pg8::StaticOrder, true, true>(lds, gm, S, E);
    meta_gemm(A, Bt, N, K, O, ACT, lds, ltid());
}

template <int K>
__device__ __forceinline__ void gemm_call_f32(const bf16* A, const bf16* Bt, float* lo, float* hi, LAS unsigned char* lds) {
    pg8::Gemm gm{A, Bt, MR, DM, K};
    pg8::StaticOrder S; S.init(MR, DM, gridDim.x, blockIdx.x);
    EpiF32Split E{lo, hi};
    pg8::gemm_phase<EpiF32Split, pg8::StaticOrder, true, true>(lds, gm, S, E);
    meta_gemm(A, Bt, DM, K, nullptr, 0, lds, ltid(), lo, hi);
}

__global__ void __launch_bounds__(NTHR, 2) trunk_fwd(Params p_unused) {
#if defined(__HIP_DEVICE_COMPILE__)
#define KP (kargs())
    extern __shared__ __attribute__((aligned(16))) unsigned char shm[];
    LAS unsigned char* lds = (LAS unsigned char*)shm;
    cg::grid_group grid = cg::this_grid();
#ifndef POST_SLEEP
#define POST_SLEEP 0
#endif
#ifdef USE_XCD_BARRIER
    volatile LAS unsigned* bst = (volatile LAS unsigned*)(lds + 131072 + 64);
    if (threadIdx.x < 2) bst[threadIdx.x] = 0u;
    __syncthreads();
    (void)xcd_barrier_post((unsigned*)(KP->ws + WS_BAR), bst);
    grid.sync();
#define GSYNC() do { XcdBarrier xb_; xb_.bar = (unsigned*)(KP->ws + WS_BAR); xb_.x = xb_xcc_id(); xb_.st = (volatile LAS unsigned*)(lds + 131072 + 64); xcd_barrier(xb_); } while (0)
#else
#define GSYNC() do { asm volatile("s_waitcnt vmcnt(0)" ::: "memory"); __threadfence(); asm volatile("s_waitcnt vmcnt(0)" ::: "memory"); grid.sync(); __threadfence(); for (int s_ = 0; s_ < POST_SLEEP; ++s_) __builtin_amdgcn_s_sleep(127); } while (0)
#endif
#define RA ((bf16*)(KP->ws + WS_RA))
#define RB ((bf16*)(KP->ws + WS_RB))
#define HM ((float*)(KP->ws + WS_HM))
    { unsigned* ctl0 = (unsigned*)(KP->ws + WS_CTL); if (blockIdx.x == 0 && threadIdx.x < 8) ctl0[64 * threadIdx.x] = 0u; }
    { const Params pc_ = *KP; conv_phase(pc_, lds, 0, gridDim.x > NB * 8 ? 1 : NL, blockIdx.x, gridDim.x, gridDim.x > NB * 8 ? 1 : 0); }
    norm_phase(nullptr, nullptr, nullptr, KP->x, KP->meta, KP->out, HM, KP->g_pre_mix, RA);
    GSYNC();
#ifdef DIAG_W
    const bool wbad = check_win(p);
#endif
    for (int l = 0; l < NL; ++l) {
        for (int gi = 0; gi < 4; ++gi) {
            if (gi == 1) {
                #ifdef PROBE_MIX2
                for (int rep = 0; rep < 2; ++rep) { if (rep) GSYNC(); const Params pm_ = *KP; mix_phase(pm_, l, lds, rep ? (l == 0 ? 0 : 4 + l) : -1); }
#else
                { const Params pm_ = *KP; mix_phase(pm_, l, lds); }
#endif
                GSYNC();
            }
            if (gi == 0) gemm_call<INC, DM, 0>(RA, (const bf16*)(KP->ws + WS_WIN + l * SZ_WIN), RB, lds);
            else if (gi == 1) gemm_call_f32<DM>(RA, (const bf16*)(KP->ws + WS_WOUT + l * SZ_WOUT), (float*)RB, (float*)RB + (size_t)MT * 512, lds);
            else if (gi == 2) gemm_call<DFF, DM, 1>(RA, (const bf16*)(KP->ws + WS_WUP + l * SZ_WUP), RB, lds);
            else gemm_call_f32<DFF>(RB, (const bf16*)(KP->ws + WS_WDN + l * SZ_WDN), (float*)RA, (float*)(KP->ws + WS_T2HI), lds);
            GSYNC();
            if (gi == 1) {
                norm_phase((const float*)RB, (const float*)RB + (size_t)MT * 512, KP->g_post_mix + l * DM, l == 0 ? KP->x : KP->out, l == 0 ? KP->meta : HM, KP->out, HM, KP->g_pre_ffn + l * DM, RA);
                GSYNC();
            } else if (gi == 3) {
                norm_phase((const float*)RA, (const float*)(KP->ws + WS_T2HI), KP->g_post_ffn + l * DM, KP->out, HM, KP->out, HM, l + 1 < NL ? KP->g_pre_mix + (l + 1) * DM : nullptr, RA);
                if (l + 1 < NL) GSYNC();
            }
        }
    }
#ifdef DIAG_W
    GSYNC();
    if (wbad && threadIdx.x == 0) KP->out[blockIdx.x] += 100000.f;
#endif
#undef RA
#undef RB
#undef HM
#endif
}

extern "C" void kernel_launch(void* const* d_in, const int* in_sizes, int n_in, void* d_out, int out_size, void* d_ws, size_t ws_size, hipStream_t stream) {
    static int grid = 0;
    if (grid == 0) {
        if (n_in != 22 || ws_size < WS_END) { fprintf(stderr, "kernel_launch: unexpected n_in %d / ws_size %zu (need %zu)\n", n_in, ws_size, (size_t)WS_END); grid = -1; return; }
        int dev = 0, cus = 0, per_cu = 0;
        hipGetDevice(&dev);
        hipDeviceGetAttribute(&cus, hipDeviceAttributeMultiprocessorCount, dev);
        if (hipFuncSetAttribute((const void*)trunk_fwd, hipFuncAttributeMaxDynamicSharedMemorySize, LDS_BYTES) != hipSuccess) { fprintf(stderr, "kernel_launch: hipFuncSetAttribute failed\n"); grid = -1; return; }
        if (hipOccupancyMaxActiveBlocksPerMultiprocessor(&per_cu, (const void*)trunk_fwd, NTHR, LDS_BYTES) != hipSuccess || per_cu < 1) { fprintf(stderr, "kernel_launch: occupancy query says %d\n", per_cu); per_cu = 1; }
        (void)hipGetLastError();
        grid = cus * per_cu;
        fprintf(stderr, "kernel_launch: grid %d (cus %d x %d)\n", grid, cus, per_cu);
    }
    if (grid < 0) return;
    if (hipMemsetAsync((char*)d_ws + WS_CTL, 0, WS_HM, stream) != hipSuccess) { fprintf(stderr, "kernel_launch: memset failed\n"); return; }
    Params p{};
    const float** f = (const float**)&p;
    for (int i = 0; i < 22; ++i) f[i] = (const float*)d_in[i];
    p.out = (float*)d_out; p.ws = (unsigned char*)d_ws;
    void* args[] = {&p};
    hipError_t e = hipLaunchCooperativeKernel((const void*)trunk_fwd, dim3(grid), dim3(NTHR), args, LDS_BYTES, stream);
    if (e != hipSuccess) fprintf(stderr, "cooperative launch failed: %s (grid %d)\n", hipGetErrorString(e), grid);
}
```
